# Optimizing an MI355X kernel written in HIP

```python
import math
import jax, jax.numpy as jnp
from jax import lax
import numpy as np

D_MODEL = 1024
BATCH = 8
SEQ = 2048
DEPTH = 4

CHUNK = 64
N_A = DEPTH // 2
N_B = DEPTH - N_A
D_FF = 2816
GMLP_WIDTH = 4 * D_MODEL
GMLP_HALF = GMLP_WIDTH // 2
GMLP_WINDOW = 128
GMLP_GROUPS = 8
GMLP_GROUP_DIM = GMLP_HALF // GMLP_GROUPS
N_HEADS = 16
HEAD_DIM = D_MODEL // N_HEADS
LEFT_CHUNKS = 8
BAND = (LEFT_CHUNKS + 1) * CHUNK
LEFT_PAD = LEFT_CHUNKS * CHUNK
MAX_REL = 4 * CHUNK
N_REL = (CHUNK - 1) + MAX_REL + 1
ALPHA = (2.0 * DEPTH) ** 0.25
BETA = (8.0 * DEPTH) ** -0.25
LN_EPS = 1e-5
N_MOD = 9

kernel_name = "hybrid_gmlp_yoco_chunk_attention_encoder"


def layer_norm(x, g, b):
    xf = x.astype(jnp.float32)
    mu = jnp.mean(xf, axis=-1, keepdims=True)
    var = jnp.mean(jnp.square(xf - mu), axis=-1, keepdims=True)
    return ((xf - mu) * lax.rsqrt(var + LN_EPS)).astype(x.dtype) * g + b


def swiglu(h, w_gu, w_down):
    gu = h @ w_gu
    g, u = jnp.split(gu, 2, axis=-1)
    return (jax.nn.silu(g) * u) @ w_down


def gmlp_mixer(h, w_in, b_in, ln_g, ln_b, w_s, b_s, w_out):
    B, S, _ = h.shape
    z = jax.nn.gelu(h @ w_in + b_in, approximate=False)
    u, v = jnp.split(z, 2, axis=-1)
    v = layer_norm(v, ln_g, ln_b)
    v = v.reshape(B, S // GMLP_WINDOW, GMLP_WINDOW, GMLP_GROUPS, GMLP_GROUP_DIM)
    t = np.arange(GMLP_WINDOW)
    mask = ((t[None, :] // CHUNK) <= (t[:, None] // CHUNK)).astype(np.float32)
    ws = w_s * jnp.asarray(mask, dtype=w_s.dtype)[None]
    s = jnp.einsum('gts,bnsgc->bntgc', ws, v) + b_s.T[None, None, :, :, None]
    return (u * s.reshape(B, S, GMLP_HALF)) @ w_out


def chunk_band_attention(h, w_q, rel_bias, w_o, k_pad, v_pad):
    B, S, _ = h.shape
    n_chunks = S // CHUNK
    q = (h @ w_q).reshape(B, n_chunks, CHUNK, N_HEADS, HEAD_DIM)
    q = jnp.transpose(q, (1, 0, 2, 3, 4))
    t = np.arange(CHUNK)
    r = np.arange(BAND)
    dist = t[:, None] + LEFT_PAD - r[None, :]
    idx = np.clip(dist, -(CHUNK - 1), MAX_REL) + (CHUNK - 1)
    bias = rel_bias[:, idx].astype(jnp.float32)
    scale = HEAD_DIM ** -0.5
    r_j = jnp.arange(BAND, dtype=jnp.int32)

    def one_chunk(args):
        n, qn = args
        start = n * CHUNK
        kn = lax.dynamic_slice_in_dim(k_pad, start, BAND, axis=1)
        vn = lax.dynamic_slice_in_dim(v_pad, start, BAND, axis=1)
        valid = (start - LEFT_PAD + r_j) >= 0
        sc = jnp.einsum('bthd,brhd->bhtr', qn, kn).astype(jnp.float32) * scale + bias
        sc = jnp.where(valid[None, None, None, :], sc, -jnp.inf)
        p = jax.nn.softmax(sc, axis=-1).astype(vn.dtype)
        return jnp.einsum('bhtr,brhd->bthd', p, vn)

    out = lax.map(one_chunk, (jnp.arange(n_chunks, dtype=jnp.int32), q))
    out = jnp.transpose(out, (1, 0, 2, 3, 4)).reshape(B, S, D_MODEL)
    return out @ w_o


def setup_inputs(seed: int = 0) -> dict:
    key = jax.random.key(seed)
    ks = jax.random.split(key, 24)
    D = D_MODEL
    f32 = jnp.float32
    nrm = lambda k, shape: jax.random.normal(k, shape, dtype=f32)
    v_scale = jnp.concatenate([jnp.ones((D,), f32), jnp.full((D,), BETA, f32)])
    return {
        "x": nrm(ks[0], (BATCH, SEQ, D)),
        "c": nrm(ks[1], (BATCH, D)),
        "w_ada": nrm(ks[2], (DEPTH, D, N_MOD * D)) * (0.1 * D ** -0.5),
        "b_ada": nrm(ks[3], (DEPTH, N_MOD * D)) * 0.01,
        "ln_g": 1.0 + 0.01 * nrm(ks[4], (DEPTH, 3, D)),
        "ln_b": 0.01 * nrm(ks[5], (DEPTH, 3, D)),
        "ffn_gu": nrm(ks[6], (DEPTH, 2, D, 2 * D_FF)) * D ** -0.5,
        "ffn_down": nrm(ks[7], (DEPTH, 2, D_FF, D)) * (BETA * D_FF ** -0.5),
        "gmlp_w_in": nrm(ks[8], (N_A, D, GMLP_WIDTH)) * D ** -0.5,
        "gmlp_b_in": 0.01 * nrm(ks[9], (N_A, GMLP_WIDTH)),
        "gmlp_ln_g": 1.0 + 0.01 * nrm(ks[10], (N_A, GMLP_HALF)),
        "gmlp_ln_b": 0.01 * nrm(ks[11], (N_A, GMLP_HALF)),
        "gmlp_w_s": nrm(ks[12], (N_A, GMLP_GROUPS, GMLP_WINDOW, GMLP_WINDOW)) * (0.5 * GMLP_WINDOW ** -0.5),
        "gmlp_b_s": 1.0 + 0.01 * nrm(ks[13], (N_A, GMLP_GROUPS, GMLP_WINDOW)),
        "gmlp_w_out": nrm(ks[14], (N_A, GMLP_HALF, D)) * (BETA * GMLP_HALF ** -0.5),
        "w_ada_kv": nrm(ks[15], (D, 2 * D)) * (0.1 * D ** -0.5),
        "b_ada_kv": 0.01 * nrm(ks[16], (2 * D,)),
        "w_kv": nrm(ks[17], (D, 2 * D)) * D ** -0.5 * v_scale[None, :],
        "attn_w_q": nrm(ks[18], (N_B, D, D)) * D ** -0.5,
        "attn_rel_bias": 0.5 * nrm(ks[19], (N_B, N_HEADS, N_REL)),
        "attn_w_o": nrm(ks[20], (N_B, D, D)) * (BETA * D ** -0.5),
    }


def reference(x, c, w_ada, b_ada, ln_g, ln_b, ffn_gu, ffn_down,
              gmlp_w_in, gmlp_b_in, gmlp_ln_g, gmlp_ln_b, gmlp_w_s, gmlp_b_s, gmlp_w_out,
              w_ada_kv, b_ada_kv, w_kv, attn_w_q, attn_rel_bias, attn_w_o):
    B, S, D = x.shape
    c_act = jax.nn.silu(c)
    k_pad = None
    v_pad = None
    for l in range(DEPTH):
        mod = (c_act @ w_ada[l] + b_ada[l]).reshape(B, 1, N_MOD, D)
        shift = [mod[:, :, 3 * i] for i in range(3)]
        scl = [mod[:, :, 3 * i + 1] for i in range(3)]
        gate = [1.0 + mod[:, :, 3 * i + 2] for i in range(3)]

        h = x * (1.0 + scl[0]) + shift[0]
        y = swiglu(h, ffn_gu[l, 0], ffn_down[l, 0])
        x = layer_norm(ALPHA * x + 0.5 * gate[0] * y, ln_g[l, 0], ln_b[l, 0])

        h = x * (1.0 + scl[1]) + shift[1]
        if l < N_A:
            y = gmlp_mixer(h, gmlp_w_in[l], gmlp_b_in[l], gmlp_ln_g[l], gmlp_ln_b[l],
                           gmlp_w_s[l], gmlp_b_s[l], gmlp_w_out[l])
        else:
            j = l - N_A
            y = chunk_band_attention(h, attn_w_q[j], attn_rel_bias[j], attn_w_o[j], k_pad, v_pad)
        x = layer_norm(ALPHA * x + gate[1] * y, ln_g[l, 1], ln_b[l, 1])

        h = x * (1.0 + scl[2]) + shift[2]
        y = swiglu(h, ffn_gu[l, 1], ffn_down[l, 1])
        x = layer_norm(ALPHA * x + 0.5 * gate[2] * y, ln_g[l, 2], ln_b[l, 2])

        if l == N_A - 1:
            mkv = (c_act @ w_ada_kv + b_ada_kv).reshape(B, 1, 2, D)
            hkv = x * (1.0 + mkv[:, :, 1]) + mkv[:, :, 0]
            kv = hkv @ w_kv
            k = kv[..., :D].reshape(B, S, N_HEADS, HEAD_DIM)
            v = kv[..., D:].reshape(B, S, N_HEADS, HEAD_DIM)
            pad = ((0, 0), (LEFT_PAD, 0), (0, 0), (0, 0))
            k_pad = jnp.pad(k, pad)
            v_pad = jnp.pad(v, pad)
    return x
```

```cpp
#include <hip/hip_runtime.h>
#include <hip/hip_cooperative_groups.h>
#include <cstdio>
namespace cg = cooperative_groups;

#define LAS __attribute__((address_space(3)))
typedef unsigned short bf16_t;
typedef short bf16x8 __attribute__((ext_vector_type(8)));
typedef float f32x4 __attribute__((ext_vector_type(4)));
typedef float f32x2 __attribute__((ext_vector_type(2)));
typedef unsigned u32x4 __attribute__((ext_vector_type(4)));
typedef unsigned u32x2 __attribute__((ext_vector_type(2)));
typedef _Float16 h16x4 __attribute__((ext_vector_type(4)));
typedef _Float16 h16x8 __attribute__((ext_vector_type(8)));

constexpr int D = 1024, NB = 8, SEQ = 2048, MTOK = NB * SEQ, DFF = 2816, GH = 2048, NMOD = 9;
constexpr float ALPHA = 1.6817928305074290f;
constexpr float LN_EPS = 1e-5f;

constexpr size_t WS_WGU = 0;
constexpr size_t WS_WDOWN = WS_WGU + 8ull * 5632 * 1024 * 2;
constexpr size_t WS_WIN = WS_WDOWN + 8ull * 1024 * 2816 * 2;
constexpr size_t WS_WOUT = WS_WIN + 2ull * 4096 * 1024 * 2;
constexpr size_t WS_WKV = WS_WOUT + 2ull * 1024 * 2048 * 2;
constexpr size_t WS_WQ = WS_WKV + 2048ull * 1024 * 2;
constexpr size_t WS_WO = WS_WQ + 2ull * 1024 * 1024 * 2;
constexpr size_t WS_WSB = WS_WO + 2ull * 1024 * 1024 * 2;
constexpr size_t WS_X = WS_WSB + 2ull * 8 * 128 * 128 * 2;
constexpr size_t WS_H = WS_X + (size_t)MTOK * D * 4;
constexpr size_t WS_ACT = WS_H + (size_t)MTOK * D * 2;
constexpr size_t WS_VT = WS_ACT + (size_t)MTOK * DFF * 2;
constexpr size_t WS_KB = WS_VT + (size_t)GH * MTOK * 2;
constexpr size_t WS_VTB = WS_KB + (size_t)MTOK * D * 2;
constexpr size_t WS_MOD = WS_VTB + (size_t)MTOK * D * 2;
constexpr size_t WS_MKV = WS_MOD + 4ull * 8 * 9216 * 4;
constexpr size_t WS_VSTAT = WS_MKV + 8ull * 2048 * 4;
constexpr size_t WS_BAR = WS_VSTAT + 2ull * MTOK * 2 * 4;
constexpr size_t WS_CNT = WS_BAR + 16384;
constexpr size_t WS_ZERO_END = WS_CNT + 12ull * 64 * 256;
constexpr size_t WS_XBUF = WS_ZERO_END;
constexpr size_t WS_VPART = WS_XBUF + (size_t)MTOK * 4 * 8;
constexpr size_t WS_END = WS_VPART + 2ull * 16 * MTOK * 2 * 4;

constexpr int LDS_STAGE = 131072;
constexpr int LDS_BYTES = LDS_STAGE + 16;
constexpr int NTHREADS = 512;

struct Params {
    const float* in[21];
    float* out;
    unsigned char* ws;
};


#define AS4 __attribute__((address_space(4)))
__device__ __forceinline__ const unsigned char* karg(int byteoff) {
    const AS4 unsigned char* ka = (const AS4 unsigned char*)__builtin_amdgcn_kernarg_segment_ptr();
    asm volatile("" : "+s"(byteoff));
    return *(const unsigned char* const AS4*)(ka + byteoff);
}
#define IN(k) ((const float*)karg(8 * (k)))
#define OUTP() ((float*)karg(8 * 21))
#define WSP() ((unsigned char*)karg(8 * 22))

typedef __bf16 bf16v2_t __attribute__((ext_vector_type(2)));
__device__ __forceinline__ unsigned cvt_pk_bf16(float lo, float hi) { const f32x2 v = {lo, hi}; return __builtin_bit_cast(unsigned, __builtin_convertvector(v, bf16v2_t)); }
__device__ __forceinline__ float bf16_lo(unsigned w) { return __uint_as_float(w << 16); }
__device__ __forceinline__ float bf16_hi(unsigned w) { return __uint_as_float(w & 0xffff0000u); }
__device__ __forceinline__ float silu_f(float x) { return x * __builtin_amdgcn_rcpf(1.0f + __expf(-x)); }
__device__ __forceinline__ f32x2 swiglu_pk(f32x2 g, f32x2 u) {
    const f32x2 s = g * (-1.4426950408889634f);
    f32x2 e; e.x = __builtin_amdgcn_exp2f(s.x); e.y = __builtin_amdgcn_exp2f(s.y);
    const f32x2 d = e + 1.0f;
    f32x2 rc; rc.x = __builtin_amdgcn_rcpf(d.x); rc.y = __builtin_amdgcn_rcpf(d.y);
    return (g * rc) * u;
}
__device__ __forceinline__ f32x4 swiglu4(f32x4 g, f32x4 u) { const f32x2 a = swiglu_pk((f32x2){g[0], g[1]}, (f32x2){u[0], u[1]}), b = swiglu_pk((f32x2){g[2], g[3]}, (f32x2){u[2], u[3]}); return (f32x4){a.x, a.y, b.x, b.y}; }
__device__ __forceinline__ f32x2 gelu_pk(f32x2 v) {
    const f32x2 av = __builtin_elementwise_abs(v), d = av * 0.2316418882f + 1.0f;
    f32x2 t; t.x = __builtin_amdgcn_rcpf(d.x); t.y = __builtin_amdgcn_rcpf(d.y);
    f32x2 q = t * 0.5307027145f + (-0.7265760135f); q = q * t + 0.7107068705f; q = q * t + (-0.142248368f); q = q * t + 0.127414796f; q = q * t;
    const f32x2 s = (v * v) * (-0.72134752044f);
    f32x2 e; e.x = __builtin_amdgcn_exp2f(s.x); e.y = __builtin_amdgcn_exp2f(s.y);
    const f32x2 m = v * (q * e), r = v - m;
    f32x2 o; o.x = v.x < 0.f ? m.x : r.x; o.y = v.y < 0.f ? m.y : r.y; return o;
}
__device__ __forceinline__ f32x4 gelu4(f32x4 v) { f32x2 a = gelu_pk((f32x2){v[0], v[1]}), b = gelu_pk((f32x2){v[2], v[3]}); return (f32x4){a.x, a.y, b.x, b.y}; }
__device__ __forceinline__ int opaque_tid() { int t = threadIdx.x; asm volatile("" : "+v"(t)); return t; }
__device__ __forceinline__ float dpp_sum16(float x) {
    x += __int_as_float(__builtin_amdgcn_update_dpp(0, __float_as_int(x), 0xB1, 0xF, 0xF, true));
    x += __int_as_float(__builtin_amdgcn_update_dpp(0, __float_as_int(x), 0x4E, 0xF, 0xF, true));
    x += __int_as_float(__builtin_amdgcn_update_dpp(0, __float_as_int(x), 0x141, 0xF, 0xF, true));
    x += __int_as_float(__builtin_amdgcn_update_dpp(0, __float_as_int(x), 0x140, 0xF, 0xF, true));
    return x;
}
__device__ __forceinline__ float xsum16(float x) { const auto r = __builtin_amdgcn_permlane16_swap(__float_as_uint(x), __float_as_uint(x), false, false); return __uint_as_float(r[0]) + __uint_as_float(r[1]); }
__device__ __forceinline__ float xsum32(float x) { const auto r = __builtin_amdgcn_permlane32_swap(__float_as_uint(x), __float_as_uint(x), false, false); return __uint_as_float(r[0]) + __uint_as_float(r[1]); }
__device__ __forceinline__ float xmax16(float x) { const auto r = __builtin_amdgcn_permlane16_swap(__float_as_uint(x), __float_as_uint(x), false, false); return fmaxf(__uint_as_float(r[0]), __uint_as_float(r[1])); }
__device__ __forceinline__ float xmax32(float x) { const auto r = __builtin_amdgcn_permlane32_swap(__float_as_uint(x), __float_as_uint(x), false, false); return fmaxf(__uint_as_float(r[0]), __uint_as_float(r[1])); }
__device__ __forceinline__ float wave_sum(float s) {
    s += __shfl_xor(s, 1); s += __shfl_xor(s, 2); s += __shfl_xor(s, 4); s += __shfl_xor(s, 8); s += __shfl_xor(s, 16); s += __shfl_xor(s, 32); return s;
}


#define XB_TMO      128
#define XB_XCNT(j)  (256  + 64 * (j))
#define XB_XSUB(j)  (1280 + 64 * (j))
#define XB_XGEN(j)  (2304 + 64 * (j))
#define XB_TOP      3328
#define XB_TOPGEN   3392
#define XCD_BAR_WORDS 3456
#define XB_SPIN_CAP (1u << 22)
__device__ __forceinline__ unsigned xb_ld(unsigned* p)              { return __hip_atomic_load(p, __ATOMIC_RELAXED, __HIP_MEMORY_SCOPE_AGENT); }
__device__ __forceinline__ unsigned xb_add(unsigned* p, unsigned v) { return __hip_atomic_fetch_add(p, v, __ATOMIC_RELAXED, __HIP_MEMORY_SCOPE_AGENT); }
__device__ __forceinline__ unsigned xb_xcc_id() { return (unsigned)__builtin_amdgcn_s_getreg((3 << 11) | 20) & 0xFu; }
#define XB_SPIN(cond, bar) do { unsigned _sp = 0; while (cond) { __builtin_amdgcn_s_sleep(1); \
    if ((++_sp & 255u) == 0u) { if (xb_ld(&(bar)[XB_TMO])) break; if (_sp > XB_SPIN_CAP) { atomicAdd(&(bar)[XB_TMO], 1u); break; } } } } while (0)
struct XcdBarrier { unsigned* bar; unsigned x; volatile LAS unsigned* st; };
__device__ __forceinline__ void xcd_barrier_post(unsigned* bar) { if (threadIdx.x == 0) (void)xb_add(&bar[XB_XCNT(xb_xcc_id())], 1u); }
__device__ __forceinline__ void xcd_barrier_complete(unsigned* bar, unsigned x, unsigned& nloc, unsigned& nx) {
    const unsigned G = gridDim.x * gridDim.y * gridDim.z;
    unsigned sum, cnt, mine, sp = 0u;
    for (;;) {
        sum = 0u; cnt = 0u; mine = 0u;
#pragma unroll
        for (unsigned j = 0; j < 16; ++j) { const unsigned c = xb_ld(&bar[XB_XCNT(j)]); sum += c; cnt += (c > 0u) ? 1u : 0u; mine = (j == x) ? c : mine; }
        if (sum == G) break;
        __builtin_amdgcn_s_sleep(1);
        if ((++sp & 255u) == 0u) { if (xb_ld(&bar[XB_TMO])) break; if (sp > XB_SPIN_CAP) { atomicAdd(&bar[XB_TMO], 1u); break; } }
    }
    nloc = mine > 0u ? mine : 1u; nx = cnt > 0u ? cnt : 1u;
}
__device__ __forceinline__ void xcd_barrier(const XcdBarrier& b) {
    asm volatile("s_waitcnt vmcnt(0)" ::: "memory");
    __syncthreads();
    if (threadIdx.x == 0) {
        unsigned* bar = b.bar;
        __builtin_amdgcn_s_waitcnt(0);
        unsigned nloc = b.st[0], nx = b.st[1];
        if (nloc == 0u) { xcd_barrier_complete(bar, b.x, nloc, nx); b.st[0] = nloc; b.st[1] = nx; }
        const unsigned old = xb_add(&bar[XB_XSUB(b.x)], 1u);
        const unsigned gen = old / nloc;
        if (old + 1u == (gen + 1u) * nloc) {
            __builtin_amdgcn_fence(__ATOMIC_RELEASE, "agent");
            asm volatile("s_waitcnt vmcnt(0)" ::: "memory");
            const unsigned og = xb_add(&bar[XB_TOP], 1u);
            const unsigned tg = og / nx;
            if (og + 1u == (tg + 1u) * nx) xb_add(&bar[XB_TOPGEN], 1u);
            else XB_SPIN(xb_ld(&bar[XB_TOPGEN]) == tg, bar);
            __builtin_amdgcn_fence(__ATOMIC_ACQUIRE, "agent");
            xb_add(&bar[XB_XGEN(b.x)], 1u);
            asm volatile("s_waitcnt vmcnt(0)" ::: "memory");
        } else {
            XB_SPIN(xb_ld(&bar[XB_XGEN(b.x)]) == gen, bar);
            __builtin_amdgcn_fence(__ATOMIC_ACQUIRE, "agent");
            asm volatile("s_waitcnt vmcnt(0)" ::: "memory");
        }
    }
    __syncthreads();
}

namespace pg8 {
constexpr int BM = 256, BK = 64, HALF = 128, HTB = HALF * BK * 2, STAGE_BYTES = 8 * HTB, NXCD = 8, WGM = 8;
__device__ __forceinline__ int lds_byte(int r, int c) { const int st = (r >> 4) * 2 + (c >> 5), rr = r & 15, cc = c & 31, ob = rr * 64 + cc * 2; return st * 1024 + (ob ^ (((ob >> 9) & 1) << 5)); }
__device__ __forceinline__ void stage_rc(int b, int& R, int& C) { const int st = b / 1024, sb = b % 1024, swz = sb ^ (((sb >> 9) & 1) << 5); R = (st >> 1) * 16 + swz / 64; C = (st & 1) * 32 + (swz % 64) / 2; }
__device__ __forceinline__ int perm32(int rho) { const int n = rho >> 4, i = rho & 15; return 8 * (i >> 2) + 4 * n + (i & 3); }

struct Unit { int pm, pn; };
struct Gemm { const bf16_t* A; const bf16_t* Bt; int M, N, K; };

struct StaticOrder {
    int nM, nN, nwg, G, c;
    __device__ void init(int M, int N, int G_, int c_) { nM = M / BM; nN = N / BM; nwg = nM * nN; G = G_; c = c_; }
    __device__ bool next(int i, Unit& u) const {
        const long L = (long)i * G + c; if (L >= nwg) return false;
        int wgid = (int)L; { const int q = nwg / NXCD, r = nwg % NXCD, xcd = wgid % NXCD, off = wgid / NXCD; wgid = (xcd < r ? xcd * (q + 1) : r * (q + 1) + (xcd - r) * q) + off; }
        const int nig = WGM * nN, gid = wgid / nig, fm = gid * WGM, gsz = (nM - fm) < WGM ? (nM - fm) : WGM;
        u.pm = fm + ((wgid % nig) % gsz); u.pn = (wgid % nig) / gsz; return true;
    }
};

template <class Epi, bool ALIGN_EPI = false, bool SP2 = false>
__device__ __forceinline__ void gemm_phase(LAS unsigned char* lds, const Gemm g, const StaticOrder S, const Epi E) {
    const int tid = opaque_tid(), wid = __builtin_amdgcn_readfirstlane(tid >> 6), lane = tid & 63, wr = wid >> 2, wc = wid & 3, fr = lane & 15, fq = lane >> 4;
    const int K = g.K, nt = K / BK;
    unsigned voffA[2], voffB[2];
#pragma unroll
    for (int i = 0; i < 2; ++i) { int R, C; stage_rc(tid * 16 + i * 8192, R, C); const int Rb = Epi::PERM ? ((R & ~31) + perm32(R & 31)) : R;
        voffA[i] = (unsigned)(R * K + C) * 2u; voffB[i] = (unsigned)(Rb * K + C) * 2u; }
    const size_t kstep = (size_t)(BK * 2);
    const size_t hstep = (size_t)HALF * K * 2;
    const size_t tstep = 2 * hstep;
    const unsigned ldsw = (unsigned)wid * 1024u;
    const int aoff = lds_byte(wr * 64 + fr, fq * 8), boff = lds_byte(wc * 32 + fr, fq * 8);
#define PG8_SA(b, h) (((b) * 2 + (h)) * HTB)
#define PG8_SB(b, h) ((4 + (b) * 2 + (h)) * HTB)
#define PG8_STAGE(bufoff, gbase, voff) do { _Pragma("unroll") for (int _i = 0; _i < 2; ++_i) \
        __builtin_amdgcn_global_load_lds((const unsigned*)((const char*)(gbase) + (voff)[_i]), (LAS unsigned*)(lds + (bufoff) + ldsw + _i * 8192), 16, 0, 0); } while (0)
#define PG8_LDA(dst, b, h) do { _Pragma("unroll") for (int m = 0; m < 4; ++m) _Pragma("unroll") for (int k = 0; k < 2; ++k) dst[m][k] = *(const LAS bf16x8*)(lds + PG8_SA(b, h) + aoff + m * 2048 + k * 1024); } while (0)
#define PG8_LDB(dst, b, h) do { _Pragma("unroll") for (int n = 0; n < 2; ++n) _Pragma("unroll") for (int k = 0; k < 2; ++k) dst[n][k] = *(const LAS bf16x8*)(lds + PG8_SB(b, h) + boff + n * 2048 + k * 1024); } while (0)
#define PG8_MMA(ai, bj, At, Bt) do { __builtin_amdgcn_s_setprio(1); _Pragma("unroll") for (int m = 0; m < 4; ++m) _Pragma("unroll") for (int n = 0; n < 2; ++n) _Pragma("unroll") for (int k = 0; k < 2; ++k) \
        acc[ai][bj][m][n] = __builtin_amdgcn_mfma_f32_16x16x32_bf16(Bt[n][k], At[m][k], acc[ai][bj][m][n], 0, 0, 0); __builtin_amdgcn_s_setprio(0); } while (0)
#define PG8_WAIT_V(n) asm volatile("s_waitcnt vmcnt(" #n ")" ::: "memory")
#define PG8_WAIT_L(n) asm volatile("s_waitcnt lgkmcnt(" #n ")" ::: "memory")
#define PG8_BAR __builtin_amdgcn_s_barrier()
#define PG8_SCHED __builtin_amdgcn_sched_barrier(0)
    Unit cur, nxt; int ui = 0;
    if (!S.next(0, cur)) return;
    f32x4 acc[2][2][4][2];
#pragma unroll
    for (int a = 0; a < 2; ++a)
#pragma unroll
        for (int b = 0; b < 2; ++b)
#pragma unroll
            for (int m = 0; m < 4; ++m)
#pragma unroll
                for (int n = 0; n < 2; ++n) acc[a][b][m][n] = (f32x4){0.f, 0.f, 0.f, 0.f};
    bf16x8 At[4][2], B0[2][2], B1[2][2];
    const char* cA = (const char*)g.A + (size_t)cur.pm * tstep; const char* cB = (const char*)g.Bt + (size_t)cur.pn * tstep;
    if (SP2) {
        PG8_STAGE(PG8_SB(0, 0), cB, voffB); PG8_STAGE(PG8_SB(0, 1), cB + hstep, voffB); PG8_STAGE(PG8_SA(0, 0), cA, voffA); PG8_STAGE(PG8_SA(0, 1), cA + hstep, voffA);
        if (wr == 1) PG8_BAR;
        PG8_WAIT_V(2); PG8_BAR;
        PG8_STAGE(PG8_SB(1, 0), cB + kstep, voffB); PG8_STAGE(PG8_SA(1, 0), cA + kstep, voffA); PG8_STAGE(PG8_SB(1, 1), cB + hstep + kstep, voffB);
        PG8_WAIT_V(6); PG8_BAR;
    } else {
        PG8_STAGE(PG8_SB(0, 0), cB, voffB); PG8_STAGE(PG8_SA(0, 0), cA, voffA); PG8_STAGE(PG8_SB(0, 1), cB + hstep, voffB); PG8_STAGE(PG8_SA(0, 1), cA + hstep, voffA);
        if (wr == 1) PG8_BAR;
        PG8_WAIT_V(4); PG8_BAR;
        PG8_STAGE(PG8_SB(1, 0), cB + kstep, voffB); PG8_STAGE(PG8_SA(1, 0), cA + kstep, voffA); PG8_STAGE(PG8_SB(1, 1), cB + hstep + kstep, voffB);
        PG8_WAIT_V(6); PG8_BAR;
    }
    for (;;) {
        const bool has_next = S.next(ui + 1, nxt);
        const char* nA = has_next ? (const char*)g.A + (size_t)nxt.pm * tstep : cA; const char* nB = has_next ? (const char*)g.Bt + (size_t)nxt.pn * tstep : cB;
        for (int t = 0; t < nt; t += 2) {
            const bool last = (t == nt - 2);
            const char* a1 = cA + (size_t)(t + 1) * kstep;
            const char* a2 = last ? nA : cA + (size_t)(t + 2) * kstep; const char* b2 = last ? nB : cB + (size_t)(t + 2) * kstep;
            const char* a3 = a2 + kstep; const char* b3 = b2 + kstep;
            if (SP2) {
            PG8_LDB(B0, 0, 0); PG8_LDB(B1, 0, 1); PG8_SCHED; PG8_LDA(At, 0, 0); PG8_STAGE(PG8_SA(1, 1), a1 + hstep, voffA);
            PG8_WAIT_V(8); PG8_WAIT_L(0); PG8_BAR; PG8_MMA(0, 0, At, B0); PG8_MMA(0, 1, At, B1); PG8_BAR; PG8_SCHED;
            PG8_LDA(At, 0, 1); PG8_STAGE(PG8_SB(0, 0), b2, voffB); PG8_STAGE(PG8_SB(0, 1), b2 + hstep, voffB); PG8_STAGE(PG8_SA(0, 0), a2, voffA);
            PG8_WAIT_V(8); PG8_WAIT_L(0); PG8_BAR; PG8_MMA(1, 0, At, B0); PG8_MMA(1, 1, At, B1); PG8_BAR; PG8_SCHED;
            PG8_LDB(B0, 1, 0); PG8_LDB(B1, 1, 1); PG8_SCHED; PG8_LDA(At, 1, 0); PG8_STAGE(PG8_SA(0, 1), a2 + hstep, voffA);
            PG8_WAIT_V(8); PG8_WAIT_L(0); PG8_BAR; PG8_MMA(0, 0, At, B0); PG8_MMA(0, 1, At, B1); PG8_BAR; PG8_SCHED;
            PG8_LDA(At, 1, 1); PG8_STAGE(PG8_SB(1, 0), b3, voffB); PG8_STAGE(PG8_SB(1, 1), b3 + hstep, voffB); PG8_STAGE(PG8_SA(1, 0), a3, voffA);
            PG8_WAIT_V(8); PG8_WAIT_L(0); PG8_BAR; PG8_MMA(1, 0, At, B0); PG8_MMA(1, 1, At, B1); PG8_BAR; PG8_SCHED;
            } else {
            PG8_LDB(B0, 0, 0); PG8_SCHED; PG8_LDA(At, 0, 0); PG8_STAGE(PG8_SA(1, 1), a1 + hstep, voffA);
            PG8_WAIT_L(8); PG8_BAR; PG8_WAIT_L(0); PG8_MMA(0, 0, At, B0); PG8_BAR; PG8_SCHED;
            PG8_LDB(B1, 0, 1); PG8_STAGE(PG8_SB(0, 0), b2, voffB);
            PG8_BAR; PG8_WAIT_L(0); PG8_MMA(0, 1, At, B1); PG8_BAR;
            PG8_LDA(At, 0, 1); PG8_STAGE(PG8_SA(0, 0), a2, voffA);
            PG8_BAR; PG8_WAIT_L(0); PG8_MMA(1, 0, At, B0); PG8_BAR; PG8_SCHED;
            PG8_STAGE(PG8_SB(0, 1), b2 + hstep, voffB);
            PG8_WAIT_V(6); PG8_BAR; PG8_MMA(1, 1, At, B1); PG8_BAR;
            PG8_LDB(B0, 1, 0); PG8_SCHED; PG8_LDA(At, 1, 0); PG8_STAGE(PG8_SA(0, 1), a2 + hstep, voffA);
            PG8_WAIT_L(8); PG8_BAR; PG8_WAIT_L(0); PG8_MMA(0, 0, At, B0); PG8_BAR; PG8_SCHED;
            PG8_LDB(B1, 1, 1); PG8_STAGE(PG8_SB(1, 0), b3, voffB);
            PG8_BAR; PG8_WAIT_L(0); PG8_MMA(0, 1, At, B1); PG8_BAR;
            PG8_LDA(At, 1, 1); PG8_STAGE(PG8_SA(1, 0), a3, voffA);
            PG8_BAR; PG8_WAIT_L(0); PG8_MMA(1, 0, At, B0); PG8_BAR; PG8_SCHED;
            PG8_STAGE(PG8_SB(1, 1), b3 + hstep, voffB);
            PG8_WAIT_V(6); PG8_BAR; PG8_MMA(1, 1, At, B1); PG8_BAR;
            }
        }
        if (ALIGN_EPI) { if (wr == 0) PG8_BAR; }
        if (!Epi::AFTER_DRAIN) E(acc, cur, wr, wc, fr, fq);
        if (!has_next) break;
#pragma unroll
        for (int a = 0; a < 2; ++a)
#pragma unroll
            for (int b = 0; b < 2; ++b)
#pragma unroll
                for (int m = 0; m < 4; ++m)
#pragma unroll
                    for (int n = 0; n < 2; ++n) acc[a][b][m][n] = (f32x4){0.f, 0.f, 0.f, 0.f};
        cur = nxt; cA = nA; cB = nB; ++ui;
        if (ALIGN_EPI) { if (wr == 1) PG8_BAR; }
    }
    PG8_WAIT_V(0);
    if (!ALIGN_EPI) { if (wr == 0) PG8_BAR; }
    PG8_BAR;
    if (Epi::AFTER_DRAIN) E.fused(acc, cur, wr, wc, fr, fq, lds, wid, lane);
#undef PG8_SA
#undef PG8_SB
#undef PG8_STAGE
#undef PG8_LDA
#undef PG8_LDB
#undef PG8_MMA
#undef PG8_WAIT_V
#undef PG8_WAIT_L
#undef PG8_BAR
#undef PG8_SCHED
}
}

typedef f32x4 AccT[2][2][4][2];

struct EpiSwiglu {
    static constexpr bool PERM = true, AFTER_DRAIN = false;
    __device__ __forceinline__ void fused(AccT&, const pg8::Unit&, int, int, int, int, LAS unsigned char*, int, int) const {}
    bf16_t* O;
    __device__ __forceinline__ void operator()(const AccT& acc, const pg8::Unit& u, int wr, int wc, int fr, int fq) const {
        const int row0 = u.pm * 256 + wr * 64 + fr, col0 = u.pn * 128 + wc * 32 + 8 * fq;
#pragma unroll
        for (int ai = 0; ai < 2; ++ai)
#pragma unroll
            for (int m = 0; m < 4; ++m) {
                bf16_t* rowp = O + (size_t)(row0 + ai * 128 + m * 16) * DFF + col0;
                const f32x4 g0 = acc[ai][0][m][0], g1 = acc[ai][0][m][1], u0 = acc[ai][1][m][0], u1 = acc[ai][1][m][1];
                const f32x4 v0 = swiglu4(g0, u0), v1 = swiglu4(g1, u1);
                u32x4 w; w.x = cvt_pk_bf16(v0[0], v0[1]); w.y = cvt_pk_bf16(v0[2], v0[3]); w.z = cvt_pk_bf16(v1[0], v1[1]); w.w = cvt_pk_bf16(v1[2], v1[3]);
                *(u32x4*)rowp = w;
            }
    }
};
struct EpiResid {
    static constexpr bool PERM = false, AFTER_DRAIN = false;
    __device__ __forceinline__ void fused(AccT&, const pg8::Unit&, int, int, int, int, LAS unsigned char*, int, int) const {}
    float* X; const float* gate; float coef;
    __device__ __forceinline__ void operator()(const AccT& acc, const pg8::Unit& u, int wr, int wc, int fr, int fq) const {
        const int row0 = u.pm * 256 + wr * 64 + fr, col0 = u.pn * 256 + wc * 32 + 4 * fq;
        const int b = u.pm >> 3;
        f32x4 gv[2][2];
#pragma unroll
        for (int bj = 0; bj < 2; ++bj)
#pragma unroll
            for (int n = 0; n < 2; ++n) gv[bj][n] = (*(const f32x4*)(gate + (size_t)b * (NMOD * D) + col0 + bj * 128 + n * 16) + 1.0f) * coef;
#pragma unroll
        for (int ai = 0; ai < 2; ++ai)
#pragma unroll
            for (int m = 0; m < 4; ++m) {
                float* rowp = X + (size_t)(row0 + ai * 128 + m * 16) * D + col0;
#pragma unroll
                for (int bj = 0; bj < 2; ++bj)
#pragma unroll
                    for (int n = 0; n < 2; ++n) { f32x4 x = *(const f32x4*)(rowp + bj * 128 + n * 16); x = x * ALPHA + gv[bj][n] * acc[ai][bj][m][n]; *(f32x4*)(rowp + bj * 128 + n * 16) = x; }
            }
    }
};

struct PanelStats {
    unsigned long long* xbuf; unsigned* cnt;
    __device__ __forceinline__ void run(const AccT& v, const pg8::Unit& u, int wr, int wc, int fr, int fq, LAS unsigned char* lds, int wid, int lane) const {
        LAS f32x2* P = (LAS f32x2*)lds;
        LAS f32x2* S = (LAS f32x2*)(lds + 8192);
#pragma unroll
        for (int ai = 0; ai < 2; ++ai)
#pragma unroll
            for (int m = 0; m < 4; ++m) {
                float s = 0.f;
#pragma unroll
                for (int bj = 0; bj < 2; ++bj)
#pragma unroll
                    for (int n = 0; n < 2; ++n) { const f32x4 x = v[ai][bj][m][n]; s += (x[0] + x[1]) + (x[2] + x[3]); }
                s = xsum32(xsum16(s));
                const float mw = s * (1.0f / 64.0f); float q = 0.f;
#pragma unroll
                for (int bj = 0; bj < 2; ++bj)
#pragma unroll
                    for (int n = 0; n < 2; ++n) { const f32x4 d = v[ai][bj][m][n] - mw; q += (d[0] * d[0] + d[1] * d[1]) + (d[2] * d[2] + d[3] * d[3]); }
                q = xsum32(xsum16(q));
                if (fq == 0) P[(ai * 128 + wr * 64 + m * 16 + fr) * 4 + wc] = (f32x2){mw, q};
            }
        asm volatile("s_waitcnt lgkmcnt(0)" ::: "memory"); __builtin_amdgcn_s_barrier(); asm volatile("" ::: "memory");
        const int row = wid * 32 + (lane & 31);
        if (lane < 32) {
            const f32x2 a = P[row * 4 + 0], b = P[row * 4 + 1], c = P[row * 4 + 2], d = P[row * 4 + 3];
            const float mt = (a.x + b.x + c.x + d.x) * 0.25f;
            const float da = a.x - mt, db = b.x - mt, dc = c.x - mt, dd = d.x - mt;
            const float m2 = (a.y + b.y) + (c.y + d.y) + 64.0f * ((da * da + db * db) + (dc * dc + dd * dd));
            unsigned long long* slot = xbuf + ((size_t)(u.pm * 256 + row) * 4 + u.pn);
            __hip_atomic_store(slot, ((unsigned long long)__float_as_uint(m2) << 32) | __float_as_uint(mt), __ATOMIC_RELAXED, __HIP_MEMORY_SCOPE_AGENT);
        }
        asm volatile("s_waitcnt vmcnt(0)" ::: "memory");
        if (lane == 0) __hip_atomic_fetch_add(cnt + 64 * u.pm, 1u, __ATOMIC_RELAXED, __HIP_MEMORY_SCOPE_AGENT);
        if (wid == 0) {
            while ((unsigned)__builtin_amdgcn_readfirstlane(__hip_atomic_load(cnt + 64 * u.pm, __ATOMIC_RELAXED, __HIP_MEMORY_SCOPE_AGENT)) < 32u) __builtin_amdgcn_s_sleep(2);
            __builtin_amdgcn_fence(__ATOMIC_ACQUIRE, "agent");
        }
        asm volatile("s_waitcnt vmcnt(0) lgkmcnt(0)" ::: "memory"); __builtin_amdgcn_s_barrier(); asm volatile("" ::: "memory");
        if (lane < 32) {
            const unsigned long long* slot = xbuf + (size_t)(u.pm * 256 + row) * 4; float mt[4], m2[4]; float ms = 0.f;
#pragma unroll
            for (int t = 0; t < 4; ++t) { const unsigned long long w = __hip_atomic_load(slot + t, __ATOMIC_RELAXED, __HIP_MEMORY_SCOPE_AGENT); mt[t] = __uint_as_float((unsigned)w); m2[t] = __uint_as_float((unsigned)(w >> 32)); ms += mt[t]; }
            const float mean = ms * 0.25f; float q = 0.f;
#pragma unroll
            for (int t = 0; t < 4; ++t) { const float dm = mt[t] - mean; q += m2[t] + 256.0f * dm * dm; }
            S[row] = (f32x2){mean, 1.0f / sqrtf(q * (1.0f / 1024.0f) + LN_EPS)};
        }
        asm volatile("s_waitcnt lgkmcnt(0)" ::: "memory"); __builtin_amdgcn_s_barrier(); asm volatile("" ::: "memory");
    }
};
template <bool F32> __device__ __forceinline__ f32x4 ldx4(const void* base, size_t off) {
    if (F32) return *(const f32x4*)((const float*)base + off);
    else return __builtin_convertvector(*(const h16x4*)((const _Float16*)base + off), f32x4);
}
template <bool F32> __device__ __forceinline__ void stx4(void* base, size_t off, f32x4 v) {
    if (F32) *(f32x4*)((float*)base + off) = v;
    else *(h16x4*)((_Float16*)base + off) = __builtin_convertvector(v, h16x4);
}
struct EpiResidLn {
    static constexpr bool PERM = true, AFTER_DRAIN = true;
    const void* Xin; void* Xout; const float* gate; const float* gam; const float* bet;
    const float* modn; bf16_t* H; const float* mkv; bf16_t* HKV; PanelStats st; float coef; int xout32;
    __device__ __forceinline__ void operator()(const AccT&, const pg8::Unit&, int, int, int, int) const {}
    __device__ __forceinline__ void load_resid(AccT& acc, const f32x4 (&gv)[2][2], size_t row0, int col0) const {
        const _Float16* X16 = (const _Float16*)Xin;
#pragma unroll
        for (int ai = 0; ai < 2; ++ai)
#pragma unroll
            for (int m = 0; m < 4; ++m) {
                const size_t roff = (row0 + ai * 128 + m * 16) * D + col0;
#pragma unroll
                for (int bj = 0; bj < 2; ++bj) {
                    const h16x8 hv = *(const h16x8*)(X16 + roff + bj * 128);
                    const f32x4 x0 = __builtin_convertvector(__builtin_shufflevector(hv, hv, 0, 1, 2, 3), f32x4), x1 = __builtin_convertvector(__builtin_shufflevector(hv, hv, 4, 5, 6, 7), f32x4);
                    acc[ai][bj][m][0] = x0 * ALPHA + gv[bj][0] * acc[ai][bj][m][0];
                    acc[ai][bj][m][1] = x1 * ALPHA + gv[bj][1] * acc[ai][bj][m][1];
                }
                asm volatile("" : "+v"(acc[ai][0][m][0]), "+v"(acc[ai][0][m][1]), "+v"(acc[ai][1][m][0]), "+v"(acc[ai][1][m][1]));
            }
    }
    template <bool F32> __device__ __forceinline__ void store_out(const AccT& acc, const LAS f32x2* S, const LAS float* PAR, size_t prow0, int rl0, int cl0, int col0) const {
#pragma unroll
        for (int ai = 0; ai < 2; ++ai)
#pragma unroll
            for (int m = 0; m < 4; ++m) {
                const int rl = rl0 + ai * 128 + m * 16;
                const f32x2 sr = S[rl];
                const size_t off = (prow0 + rl) * D + col0;
#pragma unroll
                for (int bj = 0; bj < 2; ++bj) {
                    f32x4 v[2];
#pragma unroll
                    for (int n = 0; n < 2; ++n) {
                        const int cl = cl0 + bj * 128 + n * 4;
                        const f32x4 g4 = *(const LAS f32x4*)(PAR + cl), b4 = *(const LAS f32x4*)(PAR + 256 + cl);
                        v[n] = (acc[ai][bj][m][n] - sr.x) * sr.y * g4 + b4;
                    }
                    if (F32) { *(f32x4*)((float*)Xout + off + bj * 128) = v[0]; *(f32x4*)((float*)Xout + off + bj * 128 + 4) = v[1]; }
                    else { const h16x4 a = __builtin_convertvector(v[0], h16x4), b = __builtin_convertvector(v[1], h16x4); *(h16x8*)((_Float16*)Xout + off + bj * 128) = __builtin_shufflevector(a, b, 0, 1, 2, 3, 4, 5, 6, 7); }
                    if (modn) {
                        u32x4 w;
#pragma unroll
                        for (int n = 0; n < 2; ++n) { const int cl = cl0 + bj * 128 + n * 4; const f32x4 hh = v[n] * *(const LAS f32x4*)(PAR + 768 + cl) + *(const LAS f32x4*)(PAR + 512 + cl);
                            w[2 * n] = cvt_pk_bf16(hh[0], hh[1]); w[2 * n + 1] = cvt_pk_bf16(hh[2], hh[3]); }
                        *(u32x4*)(H + off + bj * 128) = w;
                    }
                    if (mkv) {
                        u32x4 w;
#pragma unroll
                        for (int n = 0; n < 2; ++n) { const int cl = cl0 + bj * 128 + n * 4; const f32x4 hh = v[n] * *(const LAS f32x4*)(PAR + 1280 + cl) + *(const LAS f32x4*)(PAR + 1024 + cl);
                            w[2 * n] = cvt_pk_bf16(hh[0], hh[1]); w[2 * n + 1] = cvt_pk_bf16(hh[2], hh[3]); }
                        *(u32x4*)(HKV + off + bj * 128) = w;
                    }
                }
            }
    }
    __device__ __forceinline__ void fused(AccT& acc, const pg8::Unit& u, int wr, int wc, int fr, int fq, LAS unsigned char* lds, int wid, int lane) const {
        const LAS f32x2* S = (const LAS f32x2*)(lds + 8192);
        LAS float* PAR = (LAS float*)(lds + 16384);
        const int rl0 = wr * 64 + fr, cl0 = wc * 32 + 8 * fq, col0 = u.pn * 256 + cl0;
        const int b = u.pm >> 3;
        f32x4 pv = (f32x4){0.f, 0.f, 0.f, 0.f};
        {
            const int c = u.pn * 256 + lane * 4;
            if (wid == 0) pv = *(const f32x4*)(gam + c);
            else if (wid == 1) pv = *(const f32x4*)(bet + c);
            else if (wid == 2) { if (modn) pv = *(const f32x4*)(modn + (size_t)b * 9216 + c); }
            else if (wid == 3) { if (modn) pv = *(const f32x4*)(modn + (size_t)b * 9216 + 1024 + c) + 1.0f; }
            else if (wid == 4) { if (mkv) pv = *(const f32x4*)(mkv + (size_t)b * 2048 + c); }
            else if (wid == 5) { if (mkv) pv = *(const f32x4*)(mkv + (size_t)b * 2048 + 1024 + c) + 1.0f; }
        }
        {
            f32x4 gv[2][2];
#pragma unroll
            for (int bj = 0; bj < 2; ++bj)
#pragma unroll
                for (int n = 0; n < 2; ++n) gv[bj][n] = (*(const f32x4*)(gate + (size_t)b * (NMOD * D) + col0 + bj * 128 + n * 4) + 1.0f) * coef;
            load_resid(acc, gv, (size_t)(u.pm * 256 + rl0), col0);
        }
        if (wid < 6) *(LAS f32x4*)(PAR + wid * 256 + lane * 4) = pv;
        st.run(acc, u, wr, wc, fr, fq, lds, wid, lane);
        if (xout32) store_out<true>(acc, S, PAR, (size_t)u.pm * 256, rl0, cl0, col0); else store_out<false>(acc, S, PAR, (size_t)u.pm * 256, rl0, cl0, col0);
    }
};
template <int BIAS, bool GELU, bool STATS>
struct EpiBf16 {
    static constexpr bool PERM = true, AFTER_DRAIN = false;
    __device__ __forceinline__ void fused(AccT&, const pg8::Unit&, int, int, int, int, LAS unsigned char*, int, int) const {}
    bf16_t* O; int ldc; const float* bias; float scale; float* stats;
    __device__ __forceinline__ void operator()(const AccT& acc, const pg8::Unit& u, int wr, int wc, int fr, int fq) const {
        const int row0 = u.pm * 256 + wr * 64 + fr, col0 = u.pn * 256 + wc * 32 + 8 * fq;
        f32x4 bv[2][2];
#pragma unroll
        for (int bj = 0; bj < 2; ++bj)
#pragma unroll
            for (int n = 0; n < 2; ++n) bv[bj][n] = (BIAS == 1) ? *(const f32x4*)(bias + col0 + bj * 128 + 4 * n) : (f32x4){0.f, 0.f, 0.f, 0.f};
        f32x4 cs[2][2], cq[2][2];
#pragma unroll
        for (int bj = 0; bj < 2; ++bj)
#pragma unroll
            for (int n = 0; n < 2; ++n) { cs[bj][n] = (f32x4){0.f, 0.f, 0.f, 0.f}; cq[bj][n] = (f32x4){0.f, 0.f, 0.f, 0.f}; }
#pragma unroll
        for (int ai = 0; ai < 2; ++ai)
#pragma unroll
            for (int m = 0; m < 4; ++m) {
                const int r = row0 + ai * 128 + m * 16;
                bf16_t* rowp = O + (size_t)r * ldc + col0;
                float rb = 0.f; if (BIAS == 2) rb = bias[r];
#pragma unroll
                for (int bj = 0; bj < 2; ++bj) {
                    f32x4 v0 = acc[ai][bj][m][0] + bv[bj][0], v1 = acc[ai][bj][m][1] + bv[bj][1];
                    if (BIAS == 2) { v0 = v0 + rb; v1 = v1 + rb; }
                    if (GELU) { v0 = gelu4(v0); v1 = gelu4(v1); } else { v0 = v0 * scale; v1 = v1 * scale; }
                    if (STATS) { cs[bj][0] += v0; cs[bj][1] += v1; cq[bj][0] += v0 * v0; cq[bj][1] += v1 * v1; }
                    u32x4 w; w.x = cvt_pk_bf16(v0[0], v0[1]); w.y = cvt_pk_bf16(v0[2], v0[3]); w.z = cvt_pk_bf16(v1[0], v1[1]); w.w = cvt_pk_bf16(v1[2], v1[3]);
                    *(u32x4*)(rowp + bj * 128) = w;
                }
            }
        if (STATS) {
            float sel_s = 0.f, sel_q = 0.f;
#pragma unroll
            for (int bj = 0; bj < 2; ++bj)
#pragma unroll
                for (int n = 0; n < 2; ++n)
#pragma unroll
                    for (int j = 0; j < 4; ++j) {
                        const float s = dpp_sum16(cs[bj][n][j]), q = dpp_sum16(cq[bj][n][j]);
                        const int i = bj * 8 + n * 4 + j;
                        if (fr == i) { sel_s = s; sel_q = q; }
                    }
            const int ccol = col0 + (fr >> 3) * 128 + ((fr >> 2) & 1) * 4 + (fr & 3);
            *(f32x2*)(stats + ((size_t)(u.pm * 2 + wr) * ldc + ccol) * 2) = (f32x2){sel_s, sel_q};
        }
    }
};

__device__ __forceinline__ void conv_ld(f32x4 (&v)[4], const float* src, int N, int kt, int ntile, int gu) {
    const int tid = threadIdx.x;
    const int k0 = kt * 64, n0 = ntile * 128;
    int srccol0 = n0;
    if (gu) { const int pn = n0 >> 8, bj = (n0 >> 7) & 1; srccol0 = bj * DFF + pn * 128; }
    const int n4 = (tid & 31) * 4, kk = tid >> 5;
#pragma unroll
    for (int i = 0; i < 4; ++i) v[i] = __builtin_nontemporal_load((const f32x4*)(src + (size_t)(k0 + kk + 16 * i) * N + srccol0 + n4));
}
__device__ __forceinline__ void conv_scatter(LAS unsigned char* lds, const f32x4 (&v)[4]) {
    LAS float* T = (LAS float*)lds;
    const int tid = threadIdx.x;
    const int n4 = (tid & 31) * 4, kk = tid >> 5;
#pragma unroll
    for (int i = 0; i < 4; ++i) { const int k = kk + 16 * i; T[(n4 + 0) * 65 + k] = v[i][0]; T[(n4 + 1) * 65 + k] = v[i][1]; T[(n4 + 2) * 65 + k] = v[i][2]; T[(n4 + 3) * 65 + k] = v[i][3]; }
}
__device__ __forceinline__ void conv_st(LAS unsigned char* lds, int K, bf16_t* dst, int kt, int ntile) {
    LAS float* T = (LAS float*)lds;
    const int tid = threadIdx.x;
    const int k0 = kt * 64, n0 = ntile * 128;
#pragma unroll
    for (int i = 0; i < 2; ++i) {
        const int n = (tid >> 3) + 64 * i, k8 = (tid & 7) * 8;
        float f[8];
#pragma unroll
        for (int j = 0; j < 8; ++j) f[j] = T[n * 65 + k8 + j];
        u32x4 w; w.x = cvt_pk_bf16(f[0], f[1]); w.y = cvt_pk_bf16(f[2], f[3]); w.z = cvt_pk_bf16(f[4], f[5]); w.w = cvt_pk_bf16(f[6], f[7]);
        *(u32x4*)(dst + (size_t)(n0 + n) * K + k0 + k8) = w;
    }
}
struct CJob { const float* src; bf16_t* dst; int K, N, gu, ntiles; };
__device__ __forceinline__ CJob cjob(const float* src, bf16_t* dst, int K, int N, int gu) { CJob j; j.src = src; j.dst = dst; j.K = K; j.N = N; j.gu = gu; j.ntiles = (K >> 6) * (N >> 7); return j; }
__device__ __forceinline__ CJob cjob_none() { CJob j; j.src = nullptr; j.dst = nullptr; j.K = 64; j.N = 128; j.gu = 0; j.ntiles = 0; return j; }
__device__ __forceinline__ CJob cjob_id(int id) {
    unsigned char* ws = WSP();
    if (id < 0) return cjob_none();
    if (id < 8) return cjob(IN(6) + (size_t)id * 1024 * 5632, (bf16_t*)(ws + WS_WGU) + (size_t)id * 1024 * 5632, 1024, 5632, 1);
    if (id < 16) { const int m = id - 8; return cjob(IN(7) + (size_t)m * 2816 * 1024, (bf16_t*)(ws + WS_WDOWN) + (size_t)m * 2816 * 1024, 2816, 1024, 0); }
    if (id < 18) { const int m = id - 16; return cjob(IN(8) + (size_t)m * 1024 * 4096, (bf16_t*)(ws + WS_WIN) + (size_t)m * 1024 * 4096, 1024, 4096, 0); }
    if (id < 20) { const int m = id - 18; return cjob(IN(14) + (size_t)m * 2048 * 1024, (bf16_t*)(ws + WS_WOUT) + (size_t)m * 2048 * 1024, 2048, 1024, 0); }
    if (id == 20) return cjob(IN(17), (bf16_t*)(ws + WS_WKV), 1024, 2048, 0);
    if (id < 23) { const int m = id - 21; return cjob(IN(18) + (size_t)m * 1024 * 1024, (bf16_t*)(ws + WS_WQ) + (size_t)m * 1024 * 1024, 1024, 1024, 0); }
    { const int m = id - 23; return cjob(IN(20) + (size_t)m * 1024 * 1024, (bf16_t*)(ws + WS_WO) + (size_t)m * 1024 * 1024, 1024, 1024, 0); }
}
__device__ __forceinline__ void conv_multi(LAS unsigned char* lds, int ia, int ib, int ic, int id, int j, int nj) {
    const CJob a = cjob_id(ia), b = cjob_id(ib), c = cjob_id(ic), d = cjob_id(id);
    const int T = a.ntiles + b.ntiles + c.ntiles + d.ntiles;
#define CONV_SEL(t, x, tt) do { tt = (t); x = a; if (tt >= a.ntiles) { tt -= a.ntiles; x = b; if (tt >= b.ntiles) { tt -= b.ntiles; x = c; if (tt >= c.ntiles) { tt -= c.ntiles; x = d; } } } } while (0)
    if (j >= T) return;
    f32x4 v[4];
    CJob x; int tt;
    CONV_SEL(j, x, tt);
    conv_ld(v, x.src, x.N, tt / (x.N >> 7), tt % (x.N >> 7), x.gu);
    for (int t = j; t < T; t += nj) {
        conv_scatter(lds, v);
        __syncthreads();
        const CJob cur = x; const int ct = tt;
        if (t + nj < T) { CONV_SEL(t + nj, x, tt); conv_ld(v, x.src, x.N, tt / (x.N >> 7), tt % (x.N >> 7), x.gu); }
        conv_st(lds, cur.K, cur.dst, ct / (cur.N >> 7), ct % (cur.N >> 7));
        __syncthreads();
    }
#undef CONV_SEL
}

__device__ void p0_phase(LAS unsigned char* lds) {
    const int tid = threadIdx.x, G = gridDim.x, bx = blockIdx.x;
    unsigned char* ws = WSP();
    {
        const float* wsrc = IN(12); bf16_t* wd = (bf16_t*)(ws + WS_WSB);
        for (int i = bx * NTHREADS + tid; i < 2 * 8 * 128 * 128; i += G * NTHREADS) {
            const int t = (i >> 7) & 127, s = i & 127;
            const float v = ((s >> 6) <= (t >> 6)) ? wsrc[i] : 0.f;
            wd[i] = (bf16_t)(cvt_pk_bf16(v, 0.f) & 0xffffu);
        }
    }
    {
        LAS float* SC = (LAS float*)lds;
        LAS float* PART = (LAS float*)(lds + 32768);
        const float* c = IN(1);
        for (int i = tid; i < NB * D; i += NTHREADS) SC[i] = silu_f(c[i]);
        __syncthreads();
        const int wave = tid >> 6, lane = tid & 63;
        {
            const int J = bx * 152 + 4 * (lane < 38 ? lane : 0);
            const float* wp; int ld;
            if (J < 36864) { const int l = J / 9216, jj = J - l * 9216; wp = IN(2) + (size_t)l * D * 9216 + jj; ld = 9216; }
            else { wp = IN(15) + (J - 36864); ld = 2048; }
            wp += (size_t)(wave * 128) * ld;
            f32x4 a[8];
#pragma unroll
            for (int b = 0; b < 8; ++b) a[b] = (f32x4){0.f, 0.f, 0.f, 0.f};
            if (lane < 38) {
                for (int k = 0; k < 128; k += 8) {
                    f32x4 wv[8];
#pragma unroll
                    for (int kk = 0; kk < 8; ++kk) wv[kk] = __builtin_nontemporal_load((const f32x4*)(wp + (size_t)(k + kk) * ld));
#pragma unroll
                    for (int b = 0; b < 8; ++b) {
                        const f32x4 s0 = *(const LAS f32x4*)(SC + b * 1024 + wave * 128 + k), s1 = *(const LAS f32x4*)(SC + b * 1024 + wave * 128 + k + 4);
                        a[b] += wv[0] * s0[0] + wv[1] * s0[1] + wv[2] * s0[2] + wv[3] * s0[3] + wv[4] * s1[0] + wv[5] * s1[1] + wv[6] * s1[2] + wv[7] * s1[3];
                    }
                }
            }
#pragma unroll
            for (int b = 0; b < 8; ++b) *(LAS f32x4*)(PART + (wave * 64 + lane) * 32 + b * 4) = a[b];
        }
        __syncthreads();
        if (tid < 304) {
            const int b = tid / 38, L = tid - b * 38;
            f32x4 s = (f32x4){0.f, 0.f, 0.f, 0.f};
#pragma unroll
            for (int w = 0; w < 8; ++w) s += *(const LAS f32x4*)(PART + (w * 64 + L) * 32 + b * 4);
            const int J = bx * 152 + 4 * L;
            if (J < 36864) { const int l = J / 9216, jj = J - l * 9216; *(f32x4*)((float*)(ws + WS_MOD) + (size_t)(l * 8 + b) * 9216 + jj) = s + *(const f32x4*)(IN(3) + l * 9216 + jj); }
            else { const int jj = J - 36864; *(f32x4*)((float*)(ws + WS_MKV) + b * 2048 + jj) = s + *(const f32x4*)(IN(16) + jj); }
        }
        __syncthreads();
    }
    conv_multi(lds, 0, 8, 16, 18, bx, G);
}

__device__ void p0b_phase() {
    unsigned char* ws = WSP();
    const float* x = IN(0); bf16_t* H = (bf16_t*)(ws + WS_H);
    const float* mod = (const float*)(ws + WS_MOD);
    for (int i = blockIdx.x * NTHREADS + threadIdx.x; i < MTOK * D / 8; i += gridDim.x * NTHREADS) {
        const int row = i >> 7, c = (i & 127) * 8, b = row >> 11;
        const f32x4 v0 = __builtin_nontemporal_load((const f32x4*)(x + (size_t)i * 8)), v1 = __builtin_nontemporal_load((const f32x4*)(x + (size_t)i * 8 + 4));
        const float* mb = mod + (size_t)b * 9216 + c;
        const f32x4 h0 = v0 * (*(const f32x4*)(mb + 1024) + 1.0f) + *(const f32x4*)mb, h1 = v1 * (*(const f32x4*)(mb + 1028) + 1.0f) + *(const f32x4*)(mb + 4);
        u32x4 w; w.x = cvt_pk_bf16(h0[0], h0[1]); w.y = cvt_pk_bf16(h0[2], h0[3]); w.z = cvt_pk_bf16(h1[0], h1[1]); w.w = cvt_pk_bf16(h1[2], h1[3]);
        *(u32x4*)(H + (size_t)i * 8) = w;
        const h16x4 a = __builtin_convertvector(v0, h16x4), bb = __builtin_convertvector(v1, h16x4);
        *(h16x8*)((_Float16*)(ws + WS_X) + (size_t)i * 8) = __builtin_shufflevector(a, bb, 0, 1, 2, 3, 4, 5, 6, 7);
    }
}

__device__ void ln_phase(const float* X, float* XO, const float* gam, const float* bet, const float* modn  ,
                         bf16_t* H, const float* mkv  , bf16_t* HKV) {
    const int tid = opaque_tid(), lane = tid & 63, wave = tid >> 6;
    const int nwaves = gridDim.x * 8;
    for (int gw = blockIdx.x * 8 + wave; gw < MTOK / 8; gw += nwaves) {
        const int b = gw >> 8;
        f32x4 g4[4], b4[4];
#pragma unroll
        for (int i = 0; i < 4; ++i) { g4[i] = *(const f32x4*)(gam + 4 * lane + 256 * i); b4[i] = *(const f32x4*)(bet + 4 * lane + 256 * i); }
        for (int rr = 0; rr < 8; ++rr) {
            const size_t row = (size_t)gw * 8 + rr;
            const float* xp = X + row * D + 4 * lane;
            f32x4 v[4];
#pragma unroll
            for (int i = 0; i < 4; ++i) v[i] = *(const f32x4*)(xp + 256 * i);
            float s = 0.f;
#pragma unroll
            for (int i = 0; i < 4; ++i) s += (v[i][0] + v[i][1]) + (v[i][2] + v[i][3]);
            s = wave_sum(s);
            const float mean = s * (1.0f / 1024.0f);
            float q = 0.f;
#pragma unroll
            for (int i = 0; i < 4; ++i) { v[i] = v[i] - mean; q += (v[i][0] * v[i][0] + v[i][1] * v[i][1]) + (v[i][2] * v[i][2] + v[i][3] * v[i][3]); }
            q = wave_sum(q);
            const float rstd = 1.0f / sqrtf(q * (1.0f / 1024.0f) + LN_EPS);
#pragma unroll
            for (int i = 0; i < 4; ++i) { v[i] = v[i] * rstd * g4[i] + b4[i]; *(f32x4*)(XO + row * D + 4 * lane + 256 * i) = v[i]; }
            if (modn) {
#pragma unroll
                for (int i = 0; i < 4; ++i) {
                    const f32x4 sh = *(const f32x4*)(modn + (size_t)b * 9216 + 4 * lane + 256 * i), sc = *(const f32x4*)(modn + (size_t)b * 9216 + 1024 + 4 * lane + 256 * i);
                    const f32x4 h = v[i] * (sc + 1.0f) + sh;
                    u32x2 w; w.x = cvt_pk_bf16(h[0], h[1]); w.y = cvt_pk_bf16(h[2], h[3]);
                    *(u32x2*)(H + row * D + 4 * lane + 256 * i) = w;
                }
            }
            if (mkv) {
#pragma unroll
                for (int i = 0; i < 4; ++i) {
                    const f32x4 sh = *(const f32x4*)(mkv + (size_t)b * 2048 + 4 * lane + 256 * i), sc = *(const f32x4*)(mkv + (size_t)b * 2048 + 1024 + 4 * lane + 256 * i);
                    const f32x4 h = v[i] * (sc + 1.0f) + sh;
                    u32x2 w; w.x = cvt_pk_bf16(h[0], h[1]); w.y = cvt_pk_bf16(h[2], h[3]);
                    *(u32x2*)(HKV + row * D + 4 * lane + 256 * i) = w;
                }
            }
        }
    }
}

constexpr int SP_PITCH = 272;
__device__ void spatial_phase(LAS unsigned char* lds, const bf16_t* wsb  , const bf16_t* VT  , const float* vstat  ,
                              const float* lng, const float* lnb  , const float* bs  , const bf16_t* U  , bf16_t* UO) {
    const int tid = opaque_tid(), lane = tid & 63, wave = __builtin_amdgcn_readfirstlane(tid >> 6), r = lane & 15, q = lane >> 4;
    LAS unsigned char* WSL = lds;
    LAS unsigned char* VTL = lds + 128 * SP_PITCH;
    const int g = blockIdx.x & 7;
    const int s8 = tid & 15, clb = tid >> 4;
    if ((int)blockIdx.x >= 1024) return;
#pragma unroll
    for (int i = 0; i < 4; ++i) {
        const int pidx = tid + 512 * i, row = pidx >> 4, c16 = pidx & 15;
        const u32x4 w = *(const u32x4*)(wsb + (size_t)g * 16384 + row * 128 + c16 * 8);
        *(LAS u32x4*)(WSL + row * SP_PITCH + c16 * 16) = w;
    }
    LAS f32x2* GB = (LAS f32x2*)(lds + 384 * SP_PITCH);
    if (tid < 256) GB[tid] = (f32x2){lng[g * 256 + tid], lnb[g * 256 + tid]};
    LAS f32x2* MUS = (LAS f32x2*)(lds + 384 * SP_PITCH + 2048);
    for (int e = tid; e < 8 * 128; e += NTHREADS) {
        const int ui = e >> 7, tk = e & 127, unit_e = (int)blockIdx.x + (int)gridDim.x * ui;
        if (unit_e < 1024) {
            const size_t tok = (size_t)(unit_e >> 3) * 128 + tk;
            float s = 0.f, qq = 0.f;
#pragma unroll
            for (int pz = 0; pz < 16; ++pz) { const f32x2 pr = *(const f32x2*)(vstat + ((size_t)pz * MTOK + tok) * 2); s += pr.x; qq += pr.y; }
            const float mu = s * (1.0f / 2048.0f);
            MUS[e] = (f32x2){mu, 1.0f / sqrtf(fmaxf(qq * (1.0f / 2048.0f) - mu * mu, 0.f) + LN_EPS)};
        }
    }
    __syncthreads();
    float bst[8];
#pragma unroll
    for (int tt = 0; tt < 8; ++tt) bst[tt] = bs[g * 128 + 16 * tt + r];
    u32x4 vreg[8];
#define SP_LOAD(unit) do { const size_t _tok0 = (size_t)((unit) >> 3) * 128; \
        _Pragma("unroll") for (int i = 0; i < 8; ++i) vreg[i] = *(const u32x4*)(VT + (size_t)(g * 256 + clb + 32 * i) * MTOK + _tok0 + s8 * 8); } while (0)
    SP_LOAD(blockIdx.x);
    for (int unit = blockIdx.x; unit < 1024; unit += gridDim.x) {
        const size_t tok0 = (size_t)(unit >> 3) * 128;
        {
            float mu8[8], rs8[8];
            const int uidx = (unit - (int)blockIdx.x) / (int)gridDim.x;
#pragma unroll
            for (int j = 0; j < 8; ++j) { const f32x2 mr = MUS[uidx * 128 + s8 * 8 + j]; mu8[j] = mr.x; rs8[j] = mr.y; }
#pragma unroll
            for (int i = 0; i < 8; ++i) {
                const u32x4 w = vreg[i];
                const f32x2 gb = GB[clb + 32 * i];
                float f[8];
                f[0] = bf16_lo(w.x); f[1] = bf16_hi(w.x); f[2] = bf16_lo(w.y); f[3] = bf16_hi(w.y); f[4] = bf16_lo(w.z); f[5] = bf16_hi(w.z); f[6] = bf16_lo(w.w); f[7] = bf16_hi(w.w);
#pragma unroll
                for (int j = 0; j < 8; ++j) f[j] = (f[j] - mu8[j]) * rs8[j] * gb.x + gb.y;
                u32x4 o; o.x = cvt_pk_bf16(f[0], f[1]); o.y = cvt_pk_bf16(f[2], f[3]); o.z = cvt_pk_bf16(f[4], f[5]); o.w = cvt_pk_bf16(f[6], f[7]);
                *(LAS u32x4*)(VTL + (clb + 32 * i) * SP_PITCH + s8 * 16) = o;
            }
        }
        __syncthreads();
        u32x4 uw[8];
#pragma unroll
        for (int tt = 0; tt < 8; ++tt) uw[tt] = *(const u32x4*)(U + (tok0 + 16 * tt + r) * GH + g * 256 + 32 * wave + 8 * q);
        if (unit + (int)gridDim.x < 1024) SP_LOAD(unit + (int)gridDim.x);
#pragma unroll
        for (int th = 0; th < 2; ++th) {
            f32x4 acc[4][2];
#pragma unroll
            for (int t4 = 0; t4 < 4; ++t4)
#pragma unroll
                for (int cf = 0; cf < 2; ++cf) acc[t4][cf] = (f32x4){0.f, 0.f, 0.f, 0.f};
#pragma unroll
            for (int kk = 0; kk < (th == 0 ? 2 : 4); ++kk) {
                bf16x8 xf[2], yf[4];
#pragma unroll
                for (int cf = 0; cf < 2; ++cf) xf[cf] = *(const LAS bf16x8*)(VTL + (32 * wave + 8 * (r >> 2) + 4 * cf + (r & 3)) * SP_PITCH + (32 * kk + 8 * q) * 2);
#pragma unroll
                for (int t4 = 0; t4 < 4; ++t4) yf[t4] = *(const LAS bf16x8*)(WSL + (16 * (4 * th + t4) + r) * SP_PITCH + (32 * kk + 8 * q) * 2);
#pragma unroll
                for (int t4 = 0; t4 < 4; ++t4)
#pragma unroll
                    for (int cf = 0; cf < 2; ++cf) acc[t4][cf] = __builtin_amdgcn_mfma_f32_16x16x32_bf16(xf[cf], yf[t4], acc[t4][cf], 0, 0, 0);
            }
#pragma unroll
            for (int t4 = 0; t4 < 4; ++t4) {
                const int tt = 4 * th + t4;
                const size_t uoff = (tok0 + 16 * tt + r) * GH + g * 256 + 32 * wave + 8 * q;
                const f32x4 s0 = acc[t4][0] + bst[tt], s1 = acc[t4][1] + bst[tt];
                u32x4 o;
                o.x = cvt_pk_bf16(bf16_lo(uw[tt].x) * s0[0], bf16_hi(uw[tt].x) * s0[1]); o.y = cvt_pk_bf16(bf16_lo(uw[tt].y) * s0[2], bf16_hi(uw[tt].y) * s0[3]);
                o.z = cvt_pk_bf16(bf16_lo(uw[tt].z) * s1[0], bf16_hi(uw[tt].z) * s1[1]); o.w = cvt_pk_bf16(bf16_lo(uw[tt].w) * s1[2], bf16_hi(uw[tt].w) * s1[3]);
                *(u32x4*)(UO + uoff) = o;
            }
        }
        __syncthreads();
    }
#undef SP_LOAD
}

struct AttnState { float m; f32x4 O[4]; f32x4 L; };
__device__ __forceinline__ void attn_step2(AttnState& st, const bf16x8 (&qf)[2], const bf16x8 ones, LAS unsigned char* BUF, LAS float* TBL, int n, int kcA, bool vA, bool vB, int t, int r, int q) {
    f32x4 S[8];
    bf16x8 kf[8][2];
#pragma unroll
    for (int hf = 0; hf < 2; ++hf) {
        if (hf == 0 ? vA : vB) {
            LAS unsigned char* KL = BUF + hf * 16384;
            const int kc = kcA + hf;
            const int far = (n - kc >= 5) ? 1 : 0;
            const int m0 = far ? 0 : 319 - ((n - kc) * 64 + t - 4 * q);
#pragma unroll
            for (int j = 0; j < 4; ++j) {
                const int key = 16 * j + r;
                kf[4 * hf + j][0] = *(const LAS bf16x8*)(KL + key * 128 + ((q ^ (key & 7)) << 4));
                kf[4 * hf + j][1] = *(const LAS bf16x8*)(KL + key * 128 + (((4 + q) ^ (key & 7)) << 4));
                const int mj = far ? 0 : m0 + 16 * j;
                S[4 * hf + j] = *(const LAS f32x4*)(TBL + ((mj & 3) * 100 + (mj >> 2)) * 4);
            }
        }
    }
    float mx = st.m;
#pragma unroll
    for (int hf = 0; hf < 2; ++hf) {
        if (hf == 0 ? vA : vB) {
#pragma unroll
            for (int j = 0; j < 4; ++j) {
                f32x4 sv = S[4 * hf + j];
                sv = __builtin_amdgcn_mfma_f32_16x16x32_bf16(kf[4 * hf + j][0], qf[0], sv, 0, 0, 0);
                sv = __builtin_amdgcn_mfma_f32_16x16x32_bf16(kf[4 * hf + j][1], qf[1], sv, 0, 0, 0);
                S[4 * hf + j] = sv;
            }
        }
    }
    bf16x8 vf[2][2][4];
#pragma unroll
    for (int hf = 0; hf < 2; ++hf) {
        if (hf == 0 ? vA : vB) {
            LAS unsigned char* VL = BUF + hf * 16384 + 8192;
#pragma unroll
            for (int kb = 0; kb < 2; ++kb)
#pragma unroll
                for (int df = 0; df < 4; ++df) { const int d = 16 * df + r; vf[hf][kb][df] = *(const LAS bf16x8*)(VL + d * 128 + (((4 * kb + q) ^ (d & 7)) << 4)); }
        }
    }
#pragma unroll
    for (int hf = 0; hf < 2; ++hf) {
        if (hf == 0 ? vA : vB) {
#pragma unroll
            for (int j = 0; j < 4; ++j) { mx = fmaxf(fmaxf(mx, S[4 * hf + j][0]), S[4 * hf + j][1]); mx = fmaxf(fmaxf(mx, S[4 * hf + j][2]), S[4 * hf + j][3]); }
        }
    }
    mx = xmax32(xmax16(mx));
    const float alpha = __builtin_amdgcn_exp2f(st.m - mx);
    st.m = mx; st.L = st.L * alpha;
#pragma unroll
    for (int df = 0; df < 4; ++df) st.O[df] = st.O[df] * alpha;
#pragma unroll
    for (int hf = 0; hf < 2; ++hf) {
        if (hf == 0 ? vA : vB) {
#pragma unroll
            for (int j = 0; j < 4; ++j)
#pragma unroll
                for (int jj = 0; jj < 4; ++jj) S[4 * hf + j][jj] = __builtin_amdgcn_exp2f(S[4 * hf + j][jj] - mx);
#pragma unroll
            for (int kb = 0; kb < 2; ++kb) {
                const f32x4 p0 = S[4 * hf + 2 * kb], p1 = S[4 * hf + 2 * kb + 1];
                u32x4 pw; pw.x = cvt_pk_bf16(p0[0], p0[1]); pw.y = cvt_pk_bf16(p0[2], p0[3]); pw.z = cvt_pk_bf16(p1[0], p1[1]); pw.w = cvt_pk_bf16(p1[2], p1[3]);
                const bf16x8 pf = __builtin_bit_cast(bf16x8, pw);
#pragma unroll
                for (int df = 0; df < 4; ++df) st.O[df] = __builtin_amdgcn_mfma_f32_16x16x32_bf16(vf[hf][kb][df], pf, st.O[df], 0, 0, 0);
                st.L = __builtin_amdgcn_mfma_f32_16x16x32_bf16(ones, pf, st.L, 0, 0, 0);
            }
        }
    }
}
__device__ void attn_phase(LAS unsigned char* lds, const bf16_t* Q, bf16_t* AO, const bf16_t* KB, const bf16_t* VTB, const float* relb) {
    const int tid = opaque_tid(), lane = tid & 63, wave = __builtin_amdgcn_readfirstlane(tid >> 6), r = lane & 15, q = lane >> 4;
    const int qc = wave >> 2, qg = wave & 3;
    const int bx = blockIdx.x, G = gridDim.x;
    LAS float* TBL = (LAS float*)(lds + 65536);
    const int srow = tid >> 3, sc16 = tid & 7;
    const int kwoff = srow * 128 + ((sc16 ^ (srow & 7)) << 4);
    const int vg0 = 2 * sc16, vp0 = (vg0 & 8) + ((vg0 & 3) << 1) + ((vg0 >> 2) & 1), vp1 = (vg0 & 8) + (((vg0 + 1) & 3) << 1) + (((vg0 + 1) >> 2) & 1);
    const int vwoff0 = 8192 + srow * 128 + ((((vp0 >> 1) ^ (srow & 7)) << 4) | ((vp0 & 1) << 3));
    const int vwoff1 = 8192 + srow * 128 + ((((vp1 >> 1) ^ (srow & 7)) << 4) | ((vp1 & 1) << 3));
    bf16x8 ones;
#pragma unroll
    for (int x = 0; x < 8; ++x) ones[x] = (r == 0) ? (short)0x3F80 : (short)0;
    constexpr float LOG2E = 1.4426950408889634f;
    const int h = bx & 15, b = (bx >> 4) & 7;
    const int nun = (2048 - bx + G - 1) / G;
    if (nun <= 0) return;
    if (tid < 400) {
        const int s4 = tid / 100, k4 = tid - s4 * 100;
        f32x4 e;
#pragma unroll
        for (int x = 0; x < 4; ++x) { int dist = 319 - (4 * k4 + s4 + x); dist = dist < -63 ? -63 : (dist > 256 ? 256 : dist); e[x] = relb[h * 320 + dist + 63] * LOG2E; }
        *(LAS f32x4*)(TBL + tid * 4) = e;
    }
    const int t = 16 * qg + r;
    const bf16_t* kg = KB + ((size_t)b * SEQ + srow) * D + h * 64 + sc16 * 8;
    const bf16_t* vg = VTB + (size_t)(h * 64 + srow) * MTOK + (size_t)b * SEQ + sc16 * 8;
    const bf16_t* qg_p = Q + ((size_t)b * SEQ + (size_t)qc * 64 + t) * D + h * 64 + 8 * q;
#define U_NP(i) ((bx + G * (i)) >> 7)
#define U_P0(i) (U_NP(i) < 4 ? 4 - U_NP(i) : 0)
#define ATT_LOAD(R, i, p) do { const long _ko = (long)(2 * U_NP(i) - 8 + 2 * (p)) * 64; R##k0 = *(const u32x4*)(kg + _ko * D); R##v0 = *(const u32x4*)(vg + _ko); \
                               R##k1 = *(const u32x4*)(kg + (_ko + 64) * D); R##v1 = *(const u32x4*)(vg + _ko + 64); } while (0)
#define ATT_LOADQ(dst, i) do { const bf16_t* _qp = qg_p + (size_t)U_NP(i) * 128 * D; dst[0] = *(const bf16x8*)_qp; dst[1] = *(const bf16x8*)(_qp + 32); } while (0)
#define ATT_WRITE(R, bo) do { *(LAS u32x4*)(lds + (bo) + kwoff) = R##k0; *(LAS u32x2*)(lds + (bo) + vwoff0) = (u32x2){R##v0.x, R##v0.y}; *(LAS u32x2*)(lds + (bo) + vwoff1) = (u32x2){R##v0.z, R##v0.w}; \
                              *(LAS u32x4*)(lds + (bo) + 16384 + kwoff) = R##k1; *(LAS u32x2*)(lds + (bo) + 16384 + vwoff0) = (u32x2){R##v1.x, R##v1.y}; *(LAS u32x2*)(lds + (bo) + 16384 + vwoff1) = (u32x2){R##v1.z, R##v1.w}; } while (0)
#define ATT_ADV(i, p) do { if (++(p) > 4) { ++(i); (p) = ((i) < nun) ? U_P0(i) : 0; } } while (0)
#define ATT_ITER(X, Y, bc, bn) do { \
        if (ci > 0 && cp == U_P0(ci)) { qf[0] = qn[0]; qf[1] = qn[1]; st.m = -3.0e38f; st.L = (f32x4){0.f, 0.f, 0.f, 0.f}; _Pragma("unroll") for (int df = 0; df < 4; ++df) st.O[df] = (f32x4){0.f, 0.f, 0.f, 0.f}; } \
        if (li < nun) { ATT_LOAD(X, li, lp); if (lp == U_P0(li)) ATT_LOADQ(qn, li); ATT_ADV(li, lp); } \
        { const int _np = U_NP(ci), _n = 2 * _np + qc, _kc = 2 * _np - 8 + 2 * cp; const bool _va = (_kc >= _n - 8 && _kc <= _n), _vb = (_kc + 1 >= _n - 8 && _kc + 1 <= _n); \
          if (_va || _vb) attn_step2(st, qf, ones, lds + (bc), TBL, _n, _kc, _va, _vb, t, r, q); \
          if (cp == 4) { const float inv = 1.0f / __shfl(st.L[0], r); bf16_t* op = AO + ((size_t)b * SEQ + (size_t)_n * 64 + t) * D + h * 64 + 4 * q; \
            _Pragma("unroll") for (int df = 0; df < 4; ++df) { u32x2 o; o.x = cvt_pk_bf16(st.O[df][0] * inv, st.O[df][1] * inv); o.y = cvt_pk_bf16(st.O[df][2] * inv, st.O[df][3] * inv); *(u32x2*)(op + 16 * df) = o; } } } \
        ++g; \
        if (g < total) ATT_WRITE(Y, bn); \
        __syncthreads(); \
        ATT_ADV(ci, cp); \
    } while (0)
    int total = 0;
    for (int i = 0; i < nun; ++i) total += 5 - U_P0(i);
    int li = 0, lp = U_P0(0), ci = 0, cp = lp, g = 0;
    const u32x4 z4 = (u32x4){0u, 0u, 0u, 0u};
    u32x4 Ak0, Av0, Ak1, Av1, Bk0 = z4, Bv0 = z4, Bk1 = z4, Bv1 = z4;
    bf16x8 qf[2], qn[2];
    qn[0] = qn[1] = ones;
    AttnState st; st.m = -3.0e38f; st.L = (f32x4){0.f, 0.f, 0.f, 0.f};
#pragma unroll
    for (int df = 0; df < 4; ++df) st.O[df] = (f32x4){0.f, 0.f, 0.f, 0.f};
    ATT_LOAD(A, li, lp); ATT_LOADQ(qf, 0); ATT_ADV(li, lp);
    if (li < nun) { ATT_LOAD(B, li, lp); if (lp == U_P0(li)) ATT_LOADQ(qn, li); ATT_ADV(li, lp); }
    ATT_WRITE(A, 0);
    __syncthreads();
    for (;;) {
        ATT_ITER(A, B, 0, 32768);
        if (g >= total) break;
        ATT_ITER(B, A, 32768, 0);
        if (g >= total) break;
    }
#undef U_NP
#undef U_P0
#undef ATT_LOAD
#undef ATT_LOADQ
#undef ATT_WRITE
#undef ATT_ADV
#undef ATT_ITER
}

#define P_X ((float*)(WSP() + WS_X))
#define P_H ((bf16_t*)(WSP() + WS_H))
#define P_ACT ((bf16_t*)(WSP() + WS_ACT))
#define P_VT ((bf16_t*)(WSP() + WS_VT))
#define P_HKV ((bf16_t*)(WSP() + WS_VT))
#define P_KB ((bf16_t*)(WSP() + WS_KB))
#define P_VTB ((bf16_t*)(WSP() + WS_VTB))
#define P_MOD ((const float*)(WSP() + WS_MOD))
#define P_MKV ((const float*)(WSP() + WS_MKV))
#define P_W(off) ((const bf16_t*)(WSP() + (off)))
__global__ void __launch_bounds__(NTHREADS) fwd_megakernel(Params p) {
    extern __shared__ __attribute__((aligned(16))) unsigned char lds_raw[];
    LAS unsigned char* lds = (LAS unsigned char*)lds_raw;
    cg::grid_group grid = cg::this_grid();
    const int G = gridDim.x, bx = blockIdx.x;

    volatile LAS unsigned* bst = (volatile LAS unsigned*)(lds + LDS_STAGE);
    if (threadIdx.x < 4) bst[threadIdx.x] = 0u;
    __syncthreads();
#define GRID_BAR() do { XcdBarrier _b; _b.bar = (unsigned*)(WSP() + WS_BAR); _b.x = xb_xcc_id(); _b.st = bst; xcd_barrier(_b); } while (0)
    xcd_barrier_post((unsigned*)(WSP() + WS_BAR));
    if (gridDim.x == 0x7fffffffu) grid.sync();
    p0_phase(lds);
    GRID_BAR();
    p0b_phase();
    GRID_BAR();

#pragma unroll 1
    for (int sub = 0; sub < 12; ++sub) {
        const int l = sub / 3, i = sub - 3 * l;
        if (i != 1) {
            const int s = i >> 1;
            pg8::Gemm g{P_H, P_W(WS_WGU) + (size_t)(l * 2 + s) * 5632 * 1024, MTOK, 5632, D};
            pg8::StaticOrder S; S.init(MTOK, 5632, G, bx);
            EpiSwiglu E{P_ACT};
            pg8::gemm_phase<EpiSwiglu, true, true>(lds, g, S, E);
            if (bx >= 128 && sub < 10) {
                int ja, jb, jc = -1, jd = -1;
                if (sub == 0) { ja = 1; jb = 9; }
                else if (sub == 2) { ja = 2; jb = 10; jc = 17; }
                else if (sub == 3) { ja = 3; jb = 11; jc = 19; }
                else if (sub == 5) { ja = 4; jb = 12; jc = 20; }
                else if (sub == 6) { ja = 5; jb = 13; jc = 21; jd = 23; }
                else if (sub == 8) { ja = 6; jb = 14; jc = 22; jd = 24; }
                else { ja = 7; jb = 15; }
                conv_multi(lds, ja, jb, jc, jd, bx - 128, 128);
            }
        } else if (l < 2) {
            {
                pg8::Gemm g{P_H, P_W(WS_WIN) + (size_t)l * 4096 * 1024, MTOK, GH, D};
                pg8::StaticOrder S; S.init(MTOK, GH, G, bx);
                EpiBf16<1, true, false> E{P_ACT, GH, IN(9) + l * 4096, 1.0f, nullptr};
                pg8::gemm_phase<EpiBf16<1, true, false>, true, true>(lds, g, S, E);
            }
            {
                pg8::Gemm g{P_W(WS_WIN) + (size_t)l * 4096 * 1024 + (size_t)2048 * 1024, P_H, GH, MTOK, D};
                pg8::StaticOrder S; S.init(GH, MTOK, G, bx);
                EpiBf16<2, true, true> E{P_VT, MTOK, IN(9) + l * 4096 + 2048, 1.0f, (float*)(WSP() + WS_VPART) + (size_t)l * 16 * MTOK * 2};
                pg8::gemm_phase<EpiBf16<2, true, true>, true, true>(lds, g, S, E);
            }
            GRID_BAR();
            spatial_phase(lds, P_W(WS_WSB) + (size_t)l * 8 * 16384, P_VT, (const float*)(WSP() + WS_VPART) + (size_t)l * 16 * MTOK * 2,
                          IN(10) + l * GH, IN(11) + l * GH, IN(13) + l * 8 * 128, P_ACT, P_ACT);
        } else {
            const int j = l - 2;
            {
                pg8::Gemm g{P_H, P_W(WS_WQ) + (size_t)j * 1024 * 1024, MTOK, D, D};
                pg8::StaticOrder S; S.init(MTOK, D, G, bx);
                EpiBf16<0, false, false> E{P_ACT, D, nullptr, 0.125f * 1.4426950408889634f, nullptr};
                pg8::gemm_phase<EpiBf16<0, false, false>, true, true>(lds, g, S, E);
            }
            GRID_BAR();
            attn_phase(lds, P_ACT, P_ACT, P_KB, P_VTB, IN(19) + j * 16 * 320);
        }
        GRID_BAR();
        {
            const bf16_t* rB; int rK; float coef;
            if (i != 1) { rB = P_W(WS_WDOWN) + (size_t)(l * 2 + (i >> 1)) * 1024 * 2816; rK = DFF; coef = 0.5f; }
            else if (l < 2) { rB = P_W(WS_WOUT) + (size_t)l * 1024 * 2048; rK = GH; coef = 1.0f; }
            else { rB = P_W(WS_WO) + (size_t)(l - 2) * 1024 * 1024; rK = D; coef = 1.0f; }
            const bool last = (sub == 11);
            const int l2 = (i == 2) ? l + 1 : l, i2 = (i == 2) ? 0 : i + 1;
            const float* modn = last ? nullptr : P_MOD + (size_t)l2 * 8 * 9216 + (3 * i2) * 1024;
            pg8::Gemm g{P_ACT, rB, MTOK, D, rK};
            pg8::StaticOrder S; S.init(MTOK, D, G, bx);
            void* X = (void*)P_X;
            EpiResidLn E{(const void*)X, last ? (void*)OUTP() : X, P_MOD + (size_t)l * 8 * 9216 + (3 * i + 2) * 1024, IN(4) + (l * 3 + i) * D, IN(5) + (l * 3 + i) * D,
                         modn, P_H, (sub == 5) ? P_MKV : nullptr, P_HKV,
                         PanelStats{(unsigned long long*)(WSP() + WS_XBUF), (unsigned*)(WSP() + WS_CNT) + (size_t)sub * 64 * 64}, coef, last ? 1 : 0};
            pg8::gemm_phase<EpiResidLn, false, true>(lds, g, S, E);
        }
        if (sub == 11) break;
        GRID_BAR();
        if (sub == 5) {
            {
                pg8::Gemm g{P_HKV, P_W(WS_WKV), MTOK, D, D};
                pg8::StaticOrder S; S.init(MTOK, D, G, bx);
                EpiBf16<0, false, false> E{P_KB, D, nullptr, 1.0f, nullptr};
                pg8::gemm_phase<EpiBf16<0, false, false>, true, true>(lds, g, S, E);
            }
            {
                pg8::Gemm g{P_W(WS_WKV) + (size_t)1024 * 1024, P_HKV, D, MTOK, D};
                pg8::StaticOrder S; S.init(D, MTOK, G, bx);
                EpiBf16<0, false, false> E{P_VTB, MTOK, nullptr, 1.0f, nullptr};
                pg8::gemm_phase<EpiBf16<0, false, false>, true, true>(lds, g, S, E);
            }
        }
    }
}

extern "C" void kernel_launch(void* const* d_in, const int* in_sizes, int n_in, void* d_out, int out_size, void* d_ws, size_t ws_size, hipStream_t stream) {
    static int grid_blocks = 0;
    if (grid_blocks == 0) {
        if (n_in != 21 || ws_size < WS_END) { fprintf(stderr, "kernel_launch: expected 21 inputs and >= %zu bytes of workspace (got %d, %zu)\n", (size_t)WS_END, n_in, ws_size); grid_blocks = -1; return; }
        int dev = 0, cus = 0, per_cu = 0;
        hipGetDevice(&dev);
        hipDeviceGetAttribute(&cus, hipDeviceAttributeMultiprocessorCount, dev);
        if (hipFuncSetAttribute((const void*)fwd_megakernel, hipFuncAttributeMaxDynamicSharedMemorySize, LDS_BYTES) != hipSuccess) { fprintf(stderr, "kernel_launch: hipFuncSetAttribute failed\n"); grid_blocks = -1; return; }
        hipOccupancyMaxActiveBlocksPerMultiprocessor(&per_cu, (const void*)fwd_megakernel, NTHREADS, LDS_BYTES);
        if (per_cu < 1) { fprintf(stderr, "kernel_launch: occupancy query says %d blocks per CU\n", per_cu); per_cu = 1; }
        (void)hipGetLastError();
        grid_blocks = 256;
        if (cus < 256) { fprintf(stderr, "kernel_launch: this kernel needs 256 CUs (device has %d)\n", cus); grid_blocks = -1; return; }
    }
    if (grid_blocks < 0) return;
    Params p{};
    for (int i = 0; i < 21; ++i) p.in[i] = (const float*)d_in[i];
    p.out = (float*)d_out; p.ws = (unsigned char*)d_ws;
    if (hipMemsetAsync((unsigned char*)d_ws + WS_BAR, 0, WS_ZERO_END - WS_BAR, stream) != hipSuccess) { fprintf(stderr, "kernel_launch: hipMemsetAsync failed\n"); return; }
    void* args[] = {&p};
    hipError_t e = hipLaunchCooperativeKernel((const void*)fwd_megakernel, dim3(grid_blocks), dim3(NTHREADS), args, LDS_BYTES, stream);
    if (e != hipSuccess) fprintf(stderr, "cooperative launch failed: %s (grid %d)\n", hipGetErrorString(e), grid_blocks);
}
```

```cpp
#include <hip/hip_runtime.h>
#include <hip/hip_cooperative_groups.h>
#include <cstdio>
namespace cg = cooperative_groups;

#define LAS __attribute__((address_space(3)))
typedef unsigned short bf16_t;
typedef short bf16x8 __attribute__((ext_vector_type(8)));
typedef float f32x4 __attribute__((ext_vector_type(4)));
typedef float f32x2 __attribute__((ext_vector_type(2)));
typedef unsigned u32x4 __attribute__((ext_vector_type(4)));
typedef unsigned u32x2 __attribute__((ext_vector_type(2)));
typedef _Float16 h16x4 __attribute__((ext_vector_type(4)));
typedef _Float16 h16x8 __attribute__((ext_vector_type(8)));

constexpr int D = 1024, NB = 8, SEQ = 2048, MTOK = NB * SEQ, DFF = 2816, GH = 2048, NMOD = 9;
constexpr float ALPHA = 1.6817928305074290f;
constexpr float LN_EPS = 1e-5f;

constexpr size_t WS_WGU = 0;
constexpr size_t WS_WDOWN = WS_WGU + 8ull * 5632 * 1024 * 2;
constexpr size_t WS_WIN = WS_WDOWN + 8ull * 1024 * 2816 * 2;
constexpr size_t WS_WOUT = WS_WIN + 2ull * 4096 * 1024 * 2;
constexpr size_t WS_WKV = WS_WOUT + 2ull * 1024 * 2048 * 2;
constexpr size_t WS_WQ = WS_WKV + 2048ull * 1024 * 2;
constexpr size_t WS_WO = WS_WQ + 2ull * 1024 * 1024 * 2;
constexpr size_t WS_WSB = WS_WO + 2ull * 1024 * 1024 * 2;
constexpr size_t WS_X = WS_WSB + 2ull * 8 * 128 * 128 * 2;
constexpr size_t WS_H = WS_X + (size_t)MTOK * D * 4;
constexpr size_t WS_ACT = WS_H + (size_t)MTOK * D * 2;
constexpr size_t WS_VT = WS_ACT + (size_t)MTOK * DFF * 2;
constexpr size_t WS_KB = WS_VT + (size_t)GH * MTOK * 2;
constexpr size_t WS_VTB = WS_KB + (size_t)MTOK * D * 2;
constexpr size_t WS_MOD = WS_VTB + (size_t)MTOK * D * 2;
constexpr size_t WS_MKV = WS_MOD + 4ull * 8 * 9216 * 4;
constexpr size_t WS_VSTAT = WS_MKV + 8ull * 2048 * 4;
constexpr size_t WS_BAR = WS_VSTAT + 2ull * MTOK * 2 * 4;
constexpr size_t WS_CNT = WS_BAR + 16384;
constexpr size_t WS_ZERO_END = WS_CNT + 12ull * 64 * 256;
constexpr size_t WS_XBUF = WS_ZERO_END;
constexpr size_t WS_VPART = WS_XBUF + (size_t)MTOK * 4 * 8;
constexpr size_t WS_END = WS_VPART + 2ull * 16 * MTOK * 2 * 4;

constexpr int LDS_STAGE = 131072;
constexpr int LDS_BYTES = LDS_STAGE + 16;
constexpr int NTHREADS = 512;

struct Params {
    const float* in[21];
    float* out;
    unsigned char* ws;
};


#define AS4 __attribute__((address_space(4)))
__device__ __forceinline__ const unsigned char* karg(int byteoff) {
    const AS4 unsigned char* ka = (const AS4 unsigned char*)__builtin_amdgcn_kernarg_segment_ptr();
    asm volatile("" : "+s"(byteoff));
    return *(const unsigned char* const AS4*)(ka + byteoff);
}
#define IN(k) ((const float*)karg(8 * (k)))
#define OUTP() ((float*)karg(8 * 21))
#define WSP() ((unsigned char*)karg(8 * 22))

typedef __bf16 bf16v2_t __attribute__((ext_vector_type(2)));
__device__ __forceinline__ unsigned cvt_pk_bf16(float lo, float hi) { const f32x2 v = {lo, hi}; return __builtin_bit_cast(unsigned, __builtin_convertvector(v, bf16v2_t)); }
__device__ __forceinline__ float bf16_lo(unsigned w) { return __uint_as_float(w << 16); }
__device__ __forceinline__ float bf16_hi(unsigned w) { return __uint_as_float(w & 0xffff0000u); }
__device__ __forceinline__ float silu_f(float x) { return x * __builtin_amdgcn_rcpf(1.0f + __expf(-x)); }
__device__ __forceinline__ f32x2 swiglu_pk(f32x2 g, f32x2 u) {
    const f32x2 s = g * (-1.4426950408889634f);
    f32x2 e; e.x = __builtin_amdgcn_exp2f(s.x); e.y = __builtin_amdgcn_exp2f(s.y);
    const f32x2 d = e + 1.0f;
    f32x2 rc; rc.x = __builtin_amdgcn_rcpf(d.x); rc.y = __builtin_amdgcn_rcpf(d.y);
    return (g * rc) * u;
}
__device__ __forceinline__ f32x4 swiglu4(f32x4 g, f32x4 u) { const f32x2 a = swiglu_pk((f32x2){g[0], g[1]}, (f32x2){u[0], u[1]}), b = swiglu_pk((f32x2){g[2], g[3]}, (f32x2){u[2], u[3]}); return (f32x4){a.x, a.y, b.x, b.y}; }
__device__ __forceinline__ f32x2 gelu_pk(f32x2 v) {
    const f32x2 av = __builtin_elementwise_abs(v), d = av * 0.2316418882f + 1.0f;
    f32x2 t; t.x = __builtin_amdgcn_rcpf(d.x); t.y = __builtin_amdgcn_rcpf(d.y);
    f32x2 q = t * 0.5307027145f + (-0.7265760135f); q = q * t + 0.7107068705f; q = q * t + (-0.142248368f); q = q * t + 0.127414796f; q = q * t;
    const f32x2 s = (v * v) * (-0.72134752044f);
    f32x2 e; e.x = __builtin_amdgcn_exp2f(s.x); e.y = __builtin_amdgcn_exp2f(s.y);
    const f32x2 m = v * (q * e), r = v - m;
    f32x2 o; o.x = v.x < 0.f ? m.x : r.x; o.y = v.y < 0.f ? m.y : r.y; return o;
}
__device__ __forceinline__ f32x4 gelu4(f32x4 v) { f32x2 a = gelu_pk((f32x2){v[0], v[1]}), b = gelu_pk((f32x2){v[2], v[3]}); return (f32x4){a.x, a.y, b.x, b.y}; }
__device__ __forceinline__ int opaque_tid() { int t = threadIdx.x; asm volatile("" : "+v"(t)); return t; }
__device__ __forceinline__ float dpp_sum16(float x) {
    x += __int_as_float(__builtin_amdgcn_update_dpp(0, __float_as_int(x), 0xB1, 0xF, 0xF, true));
    x += __int_as_float(__builtin_amdgcn_update_dpp(0, __float_as_int(x), 0x4E, 0xF, 0xF, true));
    x += __int_as_float(__builtin_amdgcn_update_dpp(0, __float_as_int(x), 0x141, 0xF, 0xF, true));
    x += __int_as_float(__builtin_amdgcn_update_dpp(0, __float_as_int(x), 0x140, 0xF, 0xF, true));
    return x;
}
__device__ __forceinline__ float xsum16(float x) { const auto r = __builtin_amdgcn_permlane16_swap(__float_as_uint(x), __float_as_uint(x), false, false); return __uint_as_float(r[0]) + __uint_as_float(r[1]); }
__device__ __forceinline__ float xsum32(float x) { const auto r = __builtin_amdgcn_permlane32_swap(__float_as_uint(x), __float_as_uint(x), false, false); return __uint_as_float(r[0]) + __uint_as_float(r[1]); }
__device__ __forceinline__ float xmax16(float x) { const auto r = __builtin_amdgcn_permlane16_swap(__float_as_uint(x), __float_as_uint(x), false, false); return fmaxf(__uint_as_float(r[0]), __uint_as_float(r[1])); }
__device__ __forceinline__ float xmax32(float x) { const auto r = __builtin_amdgcn_permlane32_swap(__float_as_uint(x), __float_as_uint(x), false, false); return fmaxf(__uint_as_float(r[0]), __uint_as_float(r[1])); }
__device__ __forceinline__ float wave_sum(float s) {
    s += __shfl_xor(s, 1); s += __shfl_xor(s, 2); s += __shfl_xor(s, 4); s += __shfl_xor(s, 8); s += __shfl_xor(s, 16); s += __shfl_xor(s, 32); return s;
}


#define XB_TMO      128
#define XB_XCNT(j)  (256  + 64 * (j))
#define XB_XSUB(j)  (1280 + 64 * (j))
#define XB_XGEN(j)  (2304 + 64 * (j))
#define XB_TOP      3328
#define XB_TOPGEN   3392
#define XCD_BAR_WORDS 3456
#define XB_SPIN_CAP (1u << 22)
__device__ __forceinline__ unsigned xb_ld(unsigned* p)              { return __hip_atomic_load(p, __ATOMIC_RELAXED, __HIP_MEMORY_SCOPE_AGENT); }
__device__ __forceinline__ unsigned xb_add(unsigned* p, unsigned v) { return __hip_atomic_fetch_add(p, v, __ATOMIC_RELAXED, __HIP_MEMORY_SCOPE_AGENT); }
__device__ __forceinline__ unsigned xb_xcc_id() { return (unsigned)__builtin_amdgcn_s_getreg((3 << 11) | 20) & 0xFu; }
#define XB_SPIN(cond, bar) do { unsigned _sp = 0; while (cond) { __builtin_amdgcn_s_sleep(1); \
    if ((++_sp & 255u) == 0u) { if (xb_ld(&(bar)[XB_TMO])) break; if (_sp > XB_SPIN_CAP) { atomicAdd(&(bar)[XB_TMO], 1u); break; } } } } while (0)
struct XcdBarrier { unsigned* bar; unsigned x; volatile LAS unsigned* st; };
__device__ __forceinline__ void xcd_barrier_post(unsigned* bar) { if (threadIdx.x == 0) (void)xb_add(&bar[XB_XCNT(xb_xcc_id())], 1u); }
__device__ __forceinline__ void xcd_barrier_complete(unsigned* bar, unsigned x, unsigned& nloc, unsigned& nx) {
    const unsigned G = gridDim.x * gridDim.y * gridDim.z;
    unsigned sum, cnt, mine, sp = 0u;
    for (;;) {
        sum = 0u; cnt = 0u; mine = 0u;
#pragma unroll
        for (unsigned j = 0; j < 16; ++j) { const unsigned c = xb_ld(&bar[XB_XCNT(j)]); sum += c; cnt += (c > 0u) ? 1u : 0u; mine = (j == x) ? c : mine; }
        if (sum == G) break;
        __builtin_amdgcn_s_sleep(1);
        if ((++sp & 255u) == 0u) { if (xb_ld(&bar[XB_TMO])) break; if (sp > XB_SPIN_CAP) { atomicAdd(&bar[XB_TMO], 1u); break; } }
    }
    nloc = mine > 0u ? mine : 1u; nx = cnt > 0u ? cnt : 1u;
}
__device__ __forceinline__ void xcd_barrier(const XcdBarrier& b) {
    asm volatile("s_waitcnt vmcnt(0)" ::: "memory");
    __syncthreads();
    if (threadIdx.x == 0) {
        unsigned* bar = b.bar;
        __builtin_amdgcn_s_waitcnt(0);
        unsigned nloc = b.st[0], nx = b.st[1];
        if (nloc == 0u) { xcd_barrier_complete(bar, b.x, nloc, nx); b.st[0] = nloc; b.st[1] = nx; }
        const unsigned old = xb_add(&bar[XB_XSUB(b.x)], 1u);
        const unsigned gen = old / nloc;
        if (old + 1u == (gen + 1u) * nloc) {
            __builtin_amdgcn_fence(__ATOMIC_RELEASE, "agent");
            asm volatile("s_waitcnt vmcnt(0)" ::: "memory");
            const unsigned og = xb_add(&bar[XB_TOP], 1u);
            const unsigned tg = og / nx;
            if (og + 1u == (tg + 1u) * nx) xb_add(&bar[XB_TOPGEN], 1u);
            else XB_SPIN(xb_ld(&bar[XB_TOPGEN]) == tg, bar);
            __builtin_amdgcn_fence(__ATOMIC_ACQUIRE, "agent");
            xb_add(&bar[XB_XGEN(b.x)], 1u);
            asm volatile("s_waitcnt vmcnt(0)" ::: "memory");
        } else {
            XB_SPIN(xb_ld(&bar[XB_XGEN(b.x)]) == gen, bar);
            __builtin_amdgcn_fence(__ATOMIC_ACQUIRE, "agent");
            asm volatile("s_waitcnt vmcnt(0)" ::: "memory");
        }
    }
    __syncthreads();
}

namespace pg8 {
constexpr int BM = 256, BK = 64, HALF = 128, HTB = HALF * BK * 2, STAGE_BYTES = 8 * HTB, NXCD = 8, WGM = 8;
__device__ __forceinline__ int lds_byte(int r, int c) { const int st = (r >> 4) * 2 + (c >> 5), rr = r & 15, cc = c & 31, ob = rr * 64 + cc * 2; return st * 1024 + (ob ^ (((ob >> 9) & 1) << 5)); }
__device__ __forceinline__ void stage_rc(int b, int& R, int& C) { const int st = b / 1024, sb = b % 1024, swz = sb ^ (((sb >> 9) & 1) << 5); R = (st >> 1) * 16 + swz / 64; C = (st & 1) * 32 + (swz % 64) / 2; }
__device__ __forceinline__ int perm32(int rho) { const int n = rho >> 4, i = rho & 15; return 8 * (i >> 2) + 4 * n + (i & 3); }

struct Unit { int pm, pn; };
struct Gemm { const bf16_t* A; const bf16_t* Bt; int M, N, K; };

struct StaticOrder {
    int nM, nN, nwg, G, c;
    __device__ void init(int M, int N, int G_, int c_) { nM = M / BM; nN = N / BM; nwg = nM * nN; G = G_; c = c_; }
    __device__ bool next(int i, Unit& u) const {
        const long L = (long)i * G + c; if (L >= nwg) return false;
        int wgid = (int)L; { const int q = nwg / NXCD, r = nwg % NXCD, xcd = wgid % NXCD, off = wgid / NXCD; wgid = (xcd < r ? xcd * (q + 1) : r * (q + 1) + (xcd - r) * q) + off; }
        const int nig = WGM * nN, gid = wgid / nig, fm = gid * WGM, gsz = (nM - fm) < WGM ? (nM - fm) : WGM;
        u.pm = fm + ((wgid % nig) % gsz); u.pn = (wgid % nig) / gsz; return true;
    }
};

template <class Epi, bool ALIGN_EPI = false, bool SP2 = false>
__device__ __forceinline__ void gemm_phase(LAS unsigned char* lds, const Gemm g, const StaticOrder S, const Epi E) {
    const int tid = opaque_tid(), wid = __builtin_amdgcn_readfirstlane(tid >> 6), lane = tid & 63, wr = wid >> 2, wc = wid & 3, fr = lane & 15, fq = lane >> 4;
    const int K = g.K, nt = K / BK;
    unsigned voffA[2], voffB[2];
#pragma unroll
    for (int i = 0; i < 2; ++i) { int R, C; stage_rc(tid * 16 + i * 8192, R, C); const int Rb = Epi::PERM ? ((R & ~31) + perm32(R & 31)) : R;
        voffA[i] = (unsigned)(R * K + C) * 2u; voffB[i] = (unsigned)(Rb * K + C) * 2u; }
    const size_t kstep = (size_t)(BK * 2);
    const size_t hstep = (size_t)HALF * K * 2;
    const size_t tstep = 2 * hstep;
    const unsigned ldsw = (unsigned)wid * 1024u;
    const int aoff = lds_byte(wr * 64 + fr, fq * 8), boff = lds_byte(wc * 32 + fr, fq * 8);
#define PG8_SA(b, h) (((b) * 2 + (h)) * HTB)
#define PG8_SB(b, h) ((4 + (b) * 2 + (h)) * HTB)
#define PG8_STAGE(bufoff, gbase, voff) do { _Pragma("unroll") for (int _i = 0; _i < 2; ++_i) \
        __builtin_amdgcn_global_load_lds((const unsigned*)((const char*)(gbase) + (voff)[_i]), (LAS unsigned*)(lds + (bufoff) + ldsw + _i * 8192), 16, 0, 0); } while (0)
#define PG8_LDA(dst, b, h) do { _Pragma("unroll") for (int m = 0; m < 4; ++m) _Pragma("unroll") for (int k = 0; k < 2; ++k) dst[m][k] = *(const LAS bf16x8*)(lds + PG8_SA(b, h) + aoff + m * 2048 + k * 1024); } while (0)
#define PG8_LDB(dst, b, h) do { _Pragma("unroll") for (int n = 0; n < 2; ++n) _Pragma("unroll") for (int k = 0; k < 2; ++k) dst[n][k] = *(const LAS bf16x8*)(lds + PG8_SB(b, h) + boff + n * 2048 + k * 1024); } while (0)
#define PG8_MMA(ai, bj, At, Bt) do { __builtin_amdgcn_s_setprio(1); _Pragma("unroll") for (int m = 0; m < 4; ++m) _Pragma("unroll") for (int n = 0; n < 2; ++n) _Pragma("unroll") for (int k = 0; k < 2; ++k) \
        acc[ai][bj][m][n] = __builtin_amdgcn_mfma_f32_16x16x32_bf16(Bt[n][k], At[m][k], acc[ai][bj][m][n], 0, 0, 0); __builtin_amdgcn_s_setprio(0); } while (0)
#define PG8_WAIT_V(n) asm volatile("s_waitcnt vmcnt(" #n ")" ::: "memory")
#define PG8_WAIT_L(n) asm volatile("s_waitcnt lgkmcnt(" #n ")" ::: "memory")
#define PG8_BAR __builtin_amdgcn_s_barrier()
#define PG8_SCHED __builtin_amdgcn_sched_barrier(0)
    Unit cur, nxt; int ui = 0;
    if (!S.next(0, cur)) return;
    f32x4 acc[2][2][4][2];
#pragma unroll
    for (int a = 0; a < 2; ++a)
#pragma unroll
        for (int b = 0; b < 2; ++b)
#pragma unroll
            for (int m = 0; m < 4; ++m)
#pragma unroll
                for (int n = 0; n < 2; ++n) acc[a][b][m][n] = (f32x4){0.f, 0.f, 0.f, 0.f};
    bf16x8 At[4][2], B0[2][2], B1[2][2];
    const char* cA = (const char*)g.A + (size_t)cur.pm * tstep; const char* cB = (const char*)g.Bt + (size_t)cur.pn * tstep;
    if (SP2) {
        PG8_STAGE(PG8_SB(0, 0), cB, voffB); PG8_STAGE(PG8_SB(0, 1), cB + hstep, voffB); PG8_STAGE(PG8_SA(0, 0), cA, voffA); PG8_STAGE(PG8_SA(0, 1), cA + hstep, voffA);
        if (wr == 1) PG8_BAR;
        PG8_WAIT_V(2); PG8_BAR;
        PG8_STAGE(PG8_SB(1, 0), cB + kstep, voffB); PG8_STAGE(PG8_SA(1, 0), cA + kstep, voffA); PG8_STAGE(PG8_SB(1, 1), cB + hstep + kstep, voffB);
        PG8_WAIT_V(6); PG8_BAR;
    } else {
        PG8_STAGE(PG8_SB(0, 0), cB, voffB); PG8_STAGE(PG8_SA(0, 0), cA, voffA); PG8_STAGE(PG8_SB(0, 1), cB + hstep, voffB); PG8_STAGE(PG8_SA(0, 1), cA + hstep, voffA);
        if (wr == 1) PG8_BAR;
        PG8_WAIT_V(4); PG8_BAR;
        PG8_STAGE(PG8_SB(1, 0), cB + kstep, voffB); PG8_STAGE(PG8_SA(1, 0), cA + kstep, voffA); PG8_STAGE(PG8_SB(1, 1), cB + hstep + kstep, voffB);
        PG8_WAIT_V(6); PG8_BAR;
    }
    for (;;) {
        const bool has_next = S.next(ui + 1, nxt);
        const char* nA = has_next ? (const char*)g.A + (size_t)nxt.pm * tstep : cA; const char* nB = has_next ? (const char*)g.Bt + (size_t)nxt.pn * tstep : cB;
        for (int t = 0; t < nt; t += 2) {
            const bool last = (t == nt - 2);
            const char* a1 = cA + (size_t)(t + 1) * kstep;
            const char* a2 = last ? nA : cA + (size_t)(t + 2) * kstep; const char* b2 = last ? nB : cB + (size_t)(t + 2) * kstep;
            const char* a3 = a2 + kstep; const char* b3 = b2 + kstep;
            if (SP2) {
            PG8_LDB(B0, 0, 0); PG8_LDB(B1, 0, 1); PG8_SCHED; PG8_LDA(At, 0, 0); PG8_STAGE(PG8_SA(1, 1), a1 + hstep, voffA);
            PG8_WAIT_V(8); PG8_WAIT_L(0); PG8_BAR; PG8_MMA(0, 0, At, B0); PG8_MMA(0, 1, At, B1); PG8_BAR; PG8_SCHED;
            PG8_LDA(At, 0, 1); PG8_STAGE(PG8_SB(0, 0), b2, voffB); PG8_STAGE(PG8_SB(0, 1), b2 + hstep, voffB); PG8_STAGE(PG8_SA(0, 0), a2, voffA);
            PG8_WAIT_V(8); PG8_WAIT_L(0); PG8_BAR; PG8_MMA(1, 0, At, B0); PG8_MMA(1, 1, At, B1); PG8_BAR; PG8_SCHED;
            PG8_LDB(B0, 1, 0); PG8_LDB(B1, 1, 1); PG8_SCHED; PG8_LDA(At, 1, 0); PG8_STAGE(PG8_SA(0, 1), a2 + hstep, voffA);
            PG8_WAIT_V(8); PG8_WAIT_L(0); PG8_BAR; PG8_MMA(0, 0, At, B0); PG8_MMA(0, 1, At, B1); PG8_BAR; PG8_SCHED;
            PG8_LDA(At, 1, 1); PG8_STAGE(PG8_SB(1, 0), b3, voffB); PG8_STAGE(PG8_SB(1, 1), b3 + hstep, voffB); PG8_STAGE(PG8_SA(1, 0), a3, voffA);
            PG8_WAIT_V(8); PG8_WAIT_L(0); PG8_BAR; PG8_MMA(1, 0, At, B0); PG8_MMA(1, 1, At, B1); PG8_BAR; PG8_SCHED;
            } else {
            PG8_LDB(B0, 0, 0); PG8_SCHED; PG8_LDA(At, 0, 0); PG8_STAGE(PG8_SA(1, 1), a1 + hstep, voffA);
            PG8_WAIT_L(8); PG8_BAR; PG8_WAIT_L(0); PG8_MMA(0, 0, At, B0); PG8_BAR; PG8_SCHED;
            PG8_LDB(B1, 0, 1); PG8_STAGE(PG8_SB(0, 0), b2, voffB);
            PG8_BAR; PG8_WAIT_L(0); PG8_MMA(0, 1, At, B1); PG8_BAR;
            PG8_LDA(At, 0, 1); PG8_STAGE(PG8_SA(0, 0), a2, voffA);
            PG8_BAR; PG8_WAIT_L(0); PG8_MMA(1, 0, At, B0); PG8_BAR; PG8_SCHED;
            PG8_STAGE(PG8_SB(0, 1), b2 + hstep, voffB);
            PG8_WAIT_V(6); PG8_BAR; PG8_MMA(1, 1, At, B1); PG8_BAR;
            PG8_LDB(B0, 1, 0); PG8_SCHED; PG8_LDA(At, 1, 0); PG8_STAGE(PG8_SA(0, 1), a2 + hstep, voffA);
            PG8_WAIT_L(8); PG8_BAR; PG8_WAIT_L(0); PG8_MMA(0, 0, At, B0); PG8_BAR; PG8_SCHED;
            PG8_LDB(B1, 1, 1); PG8_STAGE(PG8_SB(1, 0), b3, voffB);
            PG8_BAR; PG8_WAIT_L(0); PG8_MMA(0, 1, At, B1); PG8_BAR;
            PG8_LDA(At, 1, 1); PG8_STAGE(PG8_SA(1, 0), a3, voffA);
            PG8_BAR; PG8_WAIT_L(0); PG8_MMA(1, 0, At, B0); PG8_BAR; PG8_SCHED;
            PG8_STAGE(PG8_SB(1, 1), b3 + hstep, voffB);
            PG8_WAIT_V(6); PG8_BAR; PG8_MMA(1, 1, At, B1); PG8_BAR;
            }
        }
        if (ALIGN_EPI) { if (wr == 0) PG8_BAR; }
        if (!Epi::AFTER_DRAIN) E(acc, cur, wr, wc, fr, fq);
        if (!has_next) break;
#pragma unroll
        for (int a = 0; a < 2; ++a)
#pragma unroll
            for (int b = 0; b < 2; ++b)
#pragma unroll
                for (int m = 0; m < 4; ++m)
#pragma unroll
                    for (int n = 0; n < 2; ++n) acc[a][b][m][n] = (f32x4){0.f, 0.f, 0.f, 0.f};
        cur = nxt; cA = nA; cB = nB; ++ui;
        if (ALIGN_EPI) { if (wr == 1) PG8_BAR; }
    }
    PG8_WAIT_V(0);
    if (!ALIGN_EPI) { if (wr == 0) PG8_BAR; }
    PG8_BAR;
    if (Epi::AFTER_DRAIN) E.fused(acc, cur, wr, wc, fr, fq, lds, wid, lane);
#undef PG8_SA
#undef PG8_SB
#undef PG8_STAGE
#undef PG8_LDA
#undef PG8_LDB
#undef PG8_MMA
#undef PG8_WAIT_V
#undef PG8_WAIT_L
#undef PG8_BAR
#undef PG8_SCHED
}
}

typedef f32x4 AccT[2][2][4][2];

struct EpiSwiglu {
    static constexpr bool PERM = true, AFTER_DRAIN = false;
    __device__ __forceinline__ void fused(AccT&, const pg8::Unit&, int, int, int, int, LAS unsigned char*, int, int) const {}
    bf16_t* O;
    __device__ __forceinline__ void operator()(const AccT& acc, const pg8::Unit& u, int wr, int wc, int fr, int fq) const {
        const int row0 = u.pm * 256 + wr * 64 + fr, col0 = u.pn * 128 + wc * 32 + 8 * fq;
#pragma unroll
        for (int ai = 0; ai < 2; ++ai)
#pragma unroll
            for (int m = 0; m < 4; ++m) {
                bf16_t* rowp = O + (size_t)(row0 + ai * 128 + m * 16) * DFF + col0;
                const f32x4 g0 = acc[ai][0][m][0], g1 = acc[ai][0][m][1], u0 = acc[ai][1][m][0], u1 = acc[ai][1][m][1];
                const f32x4 v0 = swiglu4(g0, u0), v1 = swiglu4(g1, u1);
                u32x4 w; w.x = cvt_pk_bf16(v0[0], v0[1]); w.y = cvt_pk_bf16(v0[2], v0[3]); w.z = cvt_pk_bf16(v1[0], v1[1]); w.w = cvt_pk_bf16(v1[2], v1[3]);
                *(u32x4*)rowp = w;
            }
    }
};
struct EpiResid {
    static constexpr bool PERM = false, AFTER_DRAIN = false;
    __device__ __forceinline__ void fused(AccT&, const pg8::Unit&, int, int, int, int, LAS unsigned char*, int, int) const {}
    float* X; const float* gate; float coef;
    __device__ __forceinline__ void operator()(const AccT& acc, const pg8::Unit& u, int wr, int wc, int fr, int fq) const {
        const int row0 = u.pm * 256 + wr * 64 + fr, col0 = u.pn * 256 + wc * 32 + 4 * fq;
        const int b = u.pm >> 3;
        f32x4 gv[2][2];
#pragma unroll
        for (int bj = 0; bj < 2; ++bj)
#pragma unroll
            for (int n = 0; n < 2; ++n) gv[bj][n] = (*(const f32x4*)(gate + (size_t)b * (NMOD * D) + col0 + bj * 128 + n * 16) + 1.0f) * coef;
#pragma unroll
        for (int ai = 0; ai < 2; ++ai)
#pragma unroll
            for (int m = 0; m < 4; ++m) {
                float* rowp = X + (size_t)(row0 + ai * 128 + m * 16) * D + col0;
#pragma unroll
                for (int bj = 0; bj < 2; ++bj)
#pragma unroll
                    for (int n = 0; n < 2; ++n) { f32x4 x = *(const f32x4*)(rowp + bj * 128 + n * 16); x = x * ALPHA + gv[bj][n] * acc[ai][bj][m][n]; *(f32x4*)(rowp + bj * 128 + n * 16) = x; }
            }
    }
};

struct PanelStats {
    unsigned long long* xbuf; unsigned* cnt;
    __device__ __forceinline__ void run(const AccT& v, const pg8::Unit& u, int wr, int wc, int fr, int fq, LAS unsigned char* lds, int wid, int lane) const {
        LAS f32x2* P = (LAS f32x2*)lds;
        LAS f32x2* S = (LAS f32x2*)(lds + 8192);
#pragma unroll
        for (int ai = 0; ai < 2; ++ai)
#pragma unroll
            for (int m = 0; m < 4; ++m) {
                float s = 0.f;
#pragma unroll
                for (int bj = 0; bj < 2; ++bj)
#pragma unroll
                    for (int n = 0; n < 2; ++n) { const f32x4 x = v[ai][bj][m][n]; s += (x[0] + x[1]) + (x[2] + x[3]); }
                s = xsum32(xsum16(s));
                const float mw = s * (1.0f / 64.0f); float q = 0.f;
#pragma unroll
                for (int bj = 0; bj < 2; ++bj)
#pragma unroll
                    for (int n = 0; n < 2; ++n) { const f32x4 d = v[ai][bj][m][n] - mw; q += (d[0] * d[0] + d[1] * d[1]) + (d[2] * d[2] + d[3] * d[3]); }
                q = xsum32(xsum16(q));
                if (fq == 0) P[(ai * 128 + wr * 64 + m * 16 + fr) * 4 + wc] = (f32x2){mw, q};
            }
        asm volatile("s_waitcnt lgkmcnt(0)" ::: "memory"); __builtin_amdgcn_s_barrier(); asm volatile("" ::: "memory");
        const int row = wid * 32 + (lane & 31);
        if (lane < 32) {
            const f32x2 a = P[row * 4 + 0], b = P[row * 4 + 1], c = P[row * 4 + 2], d = P[row * 4 + 3];
            const float mt = (a.x + b.x + c.x + d.x) * 0.25f;
            const float da = a.x - mt, db = b.x - mt, dc = c.x - mt, dd = d.x - mt;
            const float m2 = (a.y + b.y) + (c.y + d.y) + 64.0f * ((da * da + db * db) + (dc * dc + dd * dd));
            unsigned long long* slot = xbuf + ((size_t)(u.pm * 256 + row) * 4 + u.pn);
            __hip_atomic_store(slot, ((unsigned long long)__float_as_uint(m2) << 32) | __float_as_uint(mt), __ATOMIC_RELAXED, __HIP_MEMORY_SCOPE_AGENT);
        }
        asm volatile("s_waitcnt vmcnt(0)" ::: "memory");
        if (lane == 0) __hip_atomic_fetch_add(cnt + 64 * u.pm, 1u, __ATOMIC_RELAXED, __HIP_MEMORY_SCOPE_AGENT);
        if (wid == 0) {
            while ((unsigned)__builtin_amdgcn_readfirstlane(__hip_atomic_load(cnt + 64 * u.pm, __ATOMIC_RELAXED, __HIP_MEMORY_SCOPE_AGENT)) < 32u) __builtin_amdgcn_s_sleep(2);
            __builtin_amdgcn_fence(__ATOMIC_ACQUIRE, "agent");
        }
        asm volatile("s_waitcnt vmcnt(0) lgkmcnt(0)" ::: "memory"); __builtin_amdgcn_s_barrier(); asm volatile("" ::: "memory");
        if (lane < 32) {
            const unsigned long long* slot = xbuf + (size_t)(u.pm * 256 + row) * 4; float mt[4], m2[4]; float ms = 0.f;
#pragma unroll
            for (int t = 0; t < 4; ++t) { const unsigned long long w = __hip_atomic_load(slot + t, __ATOMIC_RELAXED, __HIP_MEMORY_SCOPE_AGENT); mt[t] = __uint_as_float((unsigned)w); m2[t] = __uint_as_float((unsigned)(w >> 32)); ms += mt[t]; }
            const float mean = ms * 0.25f; float q = 0.f;
#pragma unroll
            for (int t = 0; t < 4; ++t) { const float dm = mt[t] - mean; q += m2[t] + 256.0f * dm * dm; }
            S[row] = (f32x2){mean, 1.0f / sqrtf(q * (1.0f / 1024.0f) + LN_EPS)};
        }
        asm volatile("s_waitcnt lgkmcnt(0)" ::: "memory"); __builtin_amdgcn_s_barrier(); asm volatile("" ::: "memory");
    }
};
template <bool F32> __device__ __forceinline__ f32x4 ldx4(const void* base, size_t off) {
    if (F32) return *(const f32x4*)((const float*)base + off);
    else return __builtin_convertvector(*(const h16x4*)((const _Float16*)base + off), f32x4);
}
template <bool F32> __device__ __forceinline__ void stx4(void* base, size_t off, f32x4 v) {
    if (F32) *(f32x4*)((float*)base + off) = v;
    else *(h16x4*)((_Float16*)base + off) = __builtin_convertvector(v, h16x4);
}
struct EpiResidLn {
    static constexpr bool PERM = true, AFTER_DRAIN = true;
    const void* Xin; void* Xout; const float* gate; const float* gam; const float* bet;
    const float* modn; bf16_t* H; const float* mkv; bf16_t* HKV; PanelStats st; float coef; int xout32;
    __device__ __forceinline__ void operator()(const AccT&, const pg8::Unit&, int, int, int, int) const {}
    __device__ __forceinline__ void load_resid(AccT& acc, const f32x4 (&gv)[2][2], size_t row0, int col0) const {
        const _Float16* X16 = (const _Float16*)Xin;
#pragma unroll
        for (int ai = 0; ai < 2; ++ai)
#pragma unroll
            for (int m = 0; m < 4; ++m) {
                const size_t roff = (row0 + ai * 128 + m * 16) * D + col0;
#pragma unroll
                for (int bj = 0; bj < 2; ++bj) {
                    const h16x8 hv = *(const h16x8*)(X16 + roff + bj * 128);
                    const f32x4 x0 = __builtin_convertvector(__builtin_shufflevector(hv, hv, 0, 1, 2, 3), f32x4), x1 = __builtin_convertvector(__builtin_shufflevector(hv, hv, 4, 5, 6, 7), f32x4);
                    acc[ai][bj][m][0] = x0 * ALPHA + gv[bj][0] * acc[ai][bj][m][0];
                    acc[ai][bj][m][1] = x1 * ALPHA + gv[bj][1] * acc[ai][bj][m][1];
                }
                asm volatile("" : "+v"(acc[ai][0][m][0]), "+v"(acc[ai][0][m][1]), "+v"(acc[ai][1][m][0]), "+v"(acc[ai][1][m][1]));
            }
    }
    template <bool F32> __device__ __forceinline__ void store_out(const AccT& acc, const LAS f32x2* S, const LAS float* PAR, size_t prow0, int rl0, int cl0, int col0) const {
#pragma unroll
        for (int ai = 0; ai < 2; ++ai)
#pragma unroll
            for (int m = 0; m < 4; ++m) {
                const int rl = rl0 + ai * 128 + m * 16;
                const f32x2 sr = S[rl];
                const size_t off = (prow0 + rl) * D + col0;
#pragma unroll
                for (int bj = 0; bj < 2; ++bj) {
                    f32x4 v[2];
#pragma unroll
                    for (int n = 0; n < 2; ++n) {
                        const int cl = cl0 + bj * 128 + n * 4;
                        const f32x4 g4 = *(const LAS f32x4*)(PAR + cl), b4 = *(const LAS f32x4*)(PAR + 256 + cl);
                        v[n] = (acc[ai][bj][m][n] - sr.x) * sr.y * g4 + b4;
                    }
                    if (F32) { *(f32x4*)((float*)Xout + off + bj * 128) = v[0]; *(f32x4*)((float*)Xout + off + bj * 128 + 4) = v[1]; }
                    else { const h16x4 a = __builtin_convertvector(v[0], h16x4), b = __builtin_convertvector(v[1], h16x4); *(h16x8*)((_Float16*)Xout + off + bj * 128) = __builtin_shufflevector(a, b, 0, 1, 2, 3, 4, 5, 6, 7); }
                    if (modn) {
                        u32x4 w;
#pragma unroll
                        for (int n = 0; n < 2; ++n) { const int cl = cl0 + bj * 128 + n * 4; const f32x4 hh = v[n] * *(const LAS f32x4*)(PAR + 768 + cl) + *(const LAS f32x4*)(PAR + 512 + cl);
                            w[2 * n] = cvt_pk_bf16(hh[0], hh[1]); w[2 * n + 1] = cvt_pk_bf16(hh[2], hh[3]); }
                        *(u32x4*)(H + off + bj * 128) = w;
                    }
                    if (mkv) {
                        u32x4 w;
#pragma unroll
                        for (int n = 0; n < 2; ++n) { const int cl = cl0 + bj * 128 + n * 4; const f32x4 hh = v[n] * *(const LAS f32x4*)(PAR + 1280 + cl) + *(const LAS f32x4*)(PAR + 1024 + cl);
                            w[2 * n] = cvt_pk_bf16(hh[0], hh[1]); w[2 * n + 1] = cvt_pk_bf16(hh[2], hh[3]); }
                        *(u32x4*)(HKV + off + bj * 128) = w;
                    }
                }
            }
    }
    __device__ __forceinline__ void fused(AccT& acc, const pg8::Unit& u, int wr, int wc, int fr, int fq, LAS unsigned char* lds, int wid, int lane) const {
        const LAS f32x2* S = (const LAS f32x2*)(lds + 8192);
        LAS float* PAR = (LAS float*)(lds + 16384);
        const int rl0 = wr * 64 + fr, cl0 = wc * 32 + 8 * fq, col0 = u.pn * 256 + cl0;
        const int b = u.pm >> 3;
        f32x4 pv = (f32x4){0.f, 0.f, 0.f, 0.f};
        {
            const int c = u.pn * 256 + lane * 4;
            if (wid == 0) pv = *(const f32x4*)(gam + c);
            else if (wid == 1) pv = *(const f32x4*)(bet + c);
            else if (wid == 2) { if (modn) pv = *(const f32x4*)(modn + (size_t)b * 9216 + c); }
            else if (wid == 3) { if (modn) pv = *(const f32x4*)(modn + (size_t)b * 9216 + 1024 + c) + 1.0f; }
            else if (wid == 4) { if (mkv) pv = *(const f32x4*)(mkv + (size_t)b * 2048 + c); }
            else if (wid == 5) { if (mkv) pv = *(const f32x4*)(mkv + (size_t)b * 2048 + 1024 + c) + 1.0f; }
        }
        {
            f32x4 gv[2][2];
#pragma unroll
            for (int bj = 0; bj < 2; ++bj)
#pragma unroll
                for (int n = 0; n < 2; ++n) gv[bj][n] = (*(const f32x4*)(gate + (size_t)b * (NMOD * D) + col0 + bj * 128 + n * 4) + 1.0f) * coef;
            load_resid(acc, gv, (size_t)(u.pm * 256 + rl0), col0);
        }
        if (wid < 6) *(LAS f32x4*)(PAR + wid * 256 + lane * 4) = pv;
        st.run(acc, u, wr, wc, fr, fq, lds, wid, lane);
        if (xout32) store_out<true>(acc, S, PAR, (size_t)u.pm * 256, rl0, cl0, col0); else store_out<false>(acc, S, PAR, (size_t)u.pm * 256, rl0, cl0, col0);
    }
};
template <int BIAS, bool GELU, bool STATS>
struct EpiBf16 {
    static constexpr bool PERM = true, AFTER_DRAIN = false;
    __device__ __forceinline__ void fused(AccT&, const pg8::Unit&, int, int, int, int, LAS unsigned char*, int, int) const {}
    bf16_t* O; int ldc; const float* bias; float scale; float* stats;
    __device__ __forceinline__ void operator()(const AccT& acc, const pg8::Unit& u, int wr, int wc, int fr, int fq) const {
        const int row0 = u.pm * 256 + wr * 64 + fr, col0 = u.pn * 256 + wc * 32 + 8 * fq;
        f32x4 bv[2][2];
#pragma unroll
        for (int bj = 0; bj < 2; ++bj)
#pragma unroll
            for (int n = 0; n < 2; ++n) bv[bj][n] = (BIAS == 1) ? *(const f32x4*)(bias + col0 + bj * 128 + 4 * n) : (f32x4){0.f, 0.f, 0.f, 0.f};
        f32x4 cs[2][2], cq[2][2];
#pragma unroll
        for (int bj = 0; bj < 2; ++bj)
#pragma unroll
            for (int n = 0; n < 2; ++n) { cs[bj][n] = (f32x4){0.f, 0.f, 0.f, 0.f}; cq[bj][n] = (f32x4){0.f, 0.f, 0.f, 0.f}; }
#pragma unroll
        for (int ai = 0; ai < 2; ++ai)
#pragma unroll
            for (int m = 0; m < 4; ++m) {
                const int r = row0 + ai * 128 + m * 16;
                bf16_t* rowp = O + (size_t)r * ldc + col0;
                float rb = 0.f; if (BIAS == 2) rb = bias[r];
#pragma unroll
                for (int bj = 0; bj < 2; ++bj) {
                    f32x4 v0 = acc[ai][bj][m][0] + bv[bj][0], v1 = acc[ai][bj][m][1] + bv[bj][1];
                    if (BIAS == 2) { v0 = v0 + rb; v1 = v1 + rb; }
                    if (GELU) { v0 = gelu4(v0); v1 = gelu4(v1); } else { v0 = v0 * scale; v1 = v1 * scale; }
                    if (STATS) { cs[bj][0] += v0; cs[bj][1] += v1; cq[bj][0] += v0 * v0; cq[bj][1] += v1 * v1; }
                    u32x4 w; w.x = cvt_pk_bf16(v0[0], v0[1]); w.y = cvt_pk_bf16(v0[2], v0[3]); w.z = cvt_pk_bf16(v1[0], v1[1]); w.w = cvt_pk_bf16(v1[2], v1[3]);
                    *(u32x4*)(rowp + bj * 128) = w;
                }
            }
        if (STATS) {
            float sel_s = 0.f, sel_q = 0.f;
#pragma unroll
            for (int bj = 0; bj < 2; ++bj)
#pragma unroll
                for (int n = 0; n < 2; ++n)
#pragma unroll
                    for (int j = 0; j < 4; ++j) {
                        const float s = dpp_sum16(cs[bj][n][j]), q = dpp_sum16(cq[bj][n][j]);
                        const int i = bj * 8 + n * 4 + j;
                        if (fr == i) { sel_s = s; sel_q = q; }
                    }
            const int ccol = col0 + (fr >> 3) * 128 + ((fr >> 2) & 1) * 4 + (fr & 3);
            *(f32x2*)(stats + ((size_t)(u.pm * 2 + wr) * ldc + ccol) * 2) = (f32x2){sel_s, sel_q};
        }
    }
};

__device__ __forceinline__ void conv_ld(f32x4 (&v)[4], const float* src, int N, int kt, int ntile, int gu) {
    const int tid = threadIdx.x;
    const int k0 = kt * 64, n0 = ntile * 128;
    int srccol0 = n0;
    if (gu) { const int pn = n0 >> 8, bj = (n0 >> 7) & 1; srccol0 = bj * DFF + pn * 128; }
    const int n4 = (tid & 31) * 4, kk = tid >> 5;
#pragma unroll
    for (int i = 0; i < 4; ++i) v[i] = __builtin_nontemporal_load((const f32x4*)(src + (size_t)(k0 + kk + 16 * i) * N + srccol0 + n4));
}
__device__ __forceinline__ void conv_scatter(LAS unsigned char* lds, const f32x4 (&v)[4]) {
    LAS float* T = (LAS float*)lds;
    const int tid = threadIdx.x;
    const int n4 = (tid & 31) * 4, kk = tid >> 5;
#pragma unroll
    for (int i = 0; i < 4; ++i) { const int k = kk + 16 * i; T[(n4 + 0) * 65 + k] = v[i][0]; T[(n4 + 1) * 65 + k] = v[i][1]; T[(n4 + 2) * 65 + k] = v[i][2]; T[(n4 + 3) * 65 + k] = v[i][3]; }
}
__device__ __forceinline__ void conv_st(LAS unsigned char* lds, int K, bf16_t* dst, int kt, int ntile) {
    LAS float* T = (LAS float*)lds;
    const int tid = threadIdx.x;
    const int k0 = kt * 64, n0 = ntile * 128;
#pragma unroll
    for (int i = 0; i < 2; ++i) {
        const int n = (tid >> 3) + 64 * i, k8 = (tid & 7) * 8;
        float f[8];
#pragma unroll
        for (int j = 0; j < 8; ++j) f[j] = T[n * 65 + k8 + j];
        u32x4 w; w.x = cvt_pk_bf16(f[0], f[1]); w.y = cvt_pk_bf16(f[2], f[3]); w.z = cvt_pk_bf16(f[4], f[5]); w.w = cvt_pk_bf16(f[6], f[7]);
        *(u32x4*)(dst + (size_t)(n0 + n) * K + k0 + k8) = w;
    }
}
struct CJob { const float* src; bf16_t* dst; int K, N, gu, ntiles; };
__device__ __forceinline__ CJob cjob(const float* src, bf16_t* dst, int K, int N, int gu) { CJob j; j.src = src; j.dst = dst; j.K = K; j.N = N; j.gu = gu; j.ntiles = (K >> 6) * (N >> 7); return j; }
__device__ __forceinline__ CJob cjob_none() { CJob j; j.src = nullptr; j.dst = nullptr; j.K = 64; j.N = 128; j.gu = 0; j.ntiles = 0; return j; }
__device__ __forceinline__ CJob cjob_id(int id) {
    unsigned char* ws = WSP();
    if (id < 0) return cjob_none();
    if (id < 8) return cjob(IN(6) + (size_t)id * 1024 * 5632, (bf16_t*)(ws + WS_WGU) + (size_t)id * 1024 * 5632, 1024, 5632, 1);
    if (id < 16) { const int m = id - 8; return cjob(IN(7) + (size_t)m * 2816 * 1024, (bf16_t*)(ws + WS_WDOWN) + (size_t)m * 2816 * 1024, 2816, 1024, 0); }
    if (id < 18) { const int m = id - 16; return cjob(IN(8) + (size_t)m * 1024 * 4096, (bf16_t*)(ws + WS_WIN) + (size_t)m * 1024 * 4096, 1024, 4096, 0); }
    if (id < 20) { const int m = id - 18; return cjob(IN(14) + (size_t)m * 2048 * 1024, (bf16_t*)(ws + WS_WOUT) + (size_t)m * 2048 * 1024, 2048, 1024, 0); }
    if (id == 20) return cjob(IN(17), (bf16_t*)(ws + WS_WKV), 1024, 2048, 0);
    if (id < 23) { const int m = id - 21; return cjob(IN(18) + (size_t)m * 1024 * 1024, (bf16_t*)(ws + WS_WQ) + (size_t)m * 1024 * 1024, 1024, 1024, 0); }
    { const int m = id - 23; return cjob(IN(20) + (size_t)m * 1024 * 1024, (bf16_t*)(ws + WS_WO) + (size_t)m * 1024 * 1024, 1024, 1024, 0); }
}
__device__ __forceinline__ void conv_multi(LAS unsigned char* lds, int ia, int ib, int ic, int id, int j, int nj) {
    const CJob a = cjob_id(ia), b = cjob_id(ib), c = cjob_id(ic), d = cjob_id(id);
    const int T = a.ntiles + b.ntiles + c.ntiles + d.ntiles;
#define CONV_SEL(t, x, tt) do { tt = (t); x = a; if (tt >= a.ntiles) { tt -= a.ntiles; x = b; if (tt >= b.ntiles) { tt -= b.ntiles; x = c; if (tt >= c.ntiles) { tt -= c.ntiles; x = d; } } } } while (0)
    if (j >= T) return;
    f32x4 v[4];
    CJob x; int tt;
    CONV_SEL(j, x, tt);
    conv_ld(v, x.src, x.N, tt / (x.N >> 7), tt % (x.N >> 7), x.gu);
    for (int t = j; t < T; t += nj) {
        conv_scatter(lds, v);
        __syncthreads();
        const CJob cur = x; const int ct = tt;
        if (t + nj < T) { CONV_SEL(t + nj, x, tt); conv_ld(v, x.src, x.N, tt / (x.N >> 7), tt % (x.N >> 7), x.gu); }
        conv_st(lds, cur.K, cur.dst, ct / (cur.N >> 7), ct % (cur.N >> 7));
        __syncthreads();
    }
#undef CONV_SEL
}

__device__ void p0_phase(LAS unsigned char* lds) {
    const int tid = threadIdx.x, G = gridDim.x, bx = blockIdx.x;
    unsigned char* ws = WSP();
    {
        const float* wsrc = IN(12); bf16_t* wd = (bf16_t*)(ws + WS_WSB);
        for (int i = bx * NTHREADS + tid; i < 2 * 8 * 128 * 128; i += G * NTHREADS) {
            const int t = (i >> 7) & 127, s = i & 127;
            const float v = ((s >> 6) <= (t >> 6)) ? wsrc[i] : 0.f;
            wd[i] = (bf16_t)(cvt_pk_bf16(v, 0.f) & 0xffffu);
        }
    }
    {
        LAS float* SC = (LAS float*)lds;
        LAS float* PART = (LAS float*)(lds + 32768);
        const float* c = IN(1);
        for (int i = tid; i < NB * D; i += NTHREADS) SC[i] = silu_f(c[i]);
        __syncthreads();
        const int wave = tid >> 6, lane = tid & 63;
        {
            const int J = bx * 152 + 4 * (lane < 38 ? lane : 0);
            const float* wp; int ld;
            if (J < 36864) { const int l = J / 9216, jj = J - l * 9216; wp = IN(2) + (size_t)l * D * 9216 + jj; ld = 9216; }
            else { wp = IN(15) + (J - 36864); ld = 2048; }
            wp += (size_t)(wave * 128) * ld;
            f32x4 a[8];
#pragma unroll
            for (int b = 0; b < 8; ++b) a[b] = (f32x4){0.f, 0.f, 0.f, 0.f};
            if (lane < 38) {
                for (int k = 0; k < 128; k += 8) {
                    f32x4 wv[8];
#pragma unroll
                    for (int kk = 0; kk < 8; ++kk) wv[kk] = __builtin_nontemporal_load((const f32x4*)(wp + (size_t)(k + kk) * ld));
#pragma unroll
                    for (int b = 0; b < 8; ++b) {
                        const f32x4 s0 = *(const LAS f32x4*)(SC + b * 1024 + wave * 128 + k), s1 = *(const LAS f32x4*)(SC + b * 1024 + wave * 128 + k + 4);
                        a[b] += wv[0] * s0[0] + wv[1] * s0[1] + wv[2] * s0[2] + wv[3] * s0[3] + wv[4] * s1[0] + wv[5] * s1[1] + wv[6] * s1[2] + wv[7] * s1[3];
                    }
                }
            }
#pragma unroll
            for (int b = 0; b < 8; ++b) *(LAS f32x4*)(PART + (wave * 64 + lane) * 32 + b * 4) = a[b];
        }
        __syncthreads();
        if (tid < 304) {
            const int b = tid / 38, L = tid - b * 38;
            f32x4 s = (f32x4){0.f, 0.f, 0.f, 0.f};
#pragma unroll
            for (int w = 0; w < 8; ++w) s += *(const LAS f32x4*)(PART + (w * 64 + L) * 32 + b * 4);
            const int J = bx * 152 + 4 * L;
            if (J < 36864) { const int l = J / 9216, jj = J - l * 9216; *(f32x4*)((float*)(ws + WS_MOD) + (size_t)(l * 8 + b) * 9216 + jj) = s + *(const f32x4*)(IN(3) + l * 9216 + jj); }
            else { const int jj = J - 36864; *(f32x4*)((float*)(ws + WS_MKV) + b * 2048 + jj) = s + *(const f32x4*)(IN(16) + jj); }
        }
        __syncthreads();
    }
    conv_multi(lds, 0, 8, 16, 18, bx, G);
}

__device__ void p0b_phase() {
    unsigned char* ws = WSP();
    const float* x = IN(0); bf16_t* H = (bf16_t*)(ws + WS_H);
    const float* mod = (const float*)(ws + WS_MOD);
    for (int i = blockIdx.x * NTHREADS + threadIdx.x; i < MTOK * D / 8; i += gridDim.x * NTHREADS) {
        const int row = i >> 7, c = (i & 127) * 8, b = row >> 11;
        const f32x4 v0 = __builtin_nontemporal_load((const f32x4*)(x + (size_t)i * 8)), v1 = __builtin_nontemporal_load((const f32x4*)(x + (size_t)i * 8 + 4));
        const float* mb = mod + (size_t)b * 9216 + c;
        const f32x4 h0 = v0 * (*(const f32x4*)(mb + 1024) + 1.0f) + *(const f32x4*)mb, h1 = v1 * (*(const f32x4*)(mb + 1028) + 1.0f) + *(const f32x4*)(mb + 4);
        u32x4 w; w.x = cvt_pk_bf16(h0[0], h0[1]); w.y = cvt_pk_bf16(h0[2], h0[3]); w.z = cvt_pk_bf16(h1[0], h1[1]); w.w = cvt_pk_bf16(h1[2], h1[3]);
        *(u32x4*)(H + (size_t)i * 8) = w;
        const h16x4 a = __builtin_convertvector(v0, h16x4), bb = __builtin_convertvector(v1, h16x4);
        *(h16x8*)((_Float16*)(ws + WS_X) + (size_t)i * 8) = __builtin_shufflevector(a, bb, 0, 1, 2, 3, 4, 5, 6, 7);
    }
}

__device__ void ln_phase(const float* X, float* XO, const float* gam, const float* bet, const float* modn  ,
                         bf16_t* H, const float* mkv  , bf16_t* HKV) {
    const int tid = opaque_tid(), lane = tid & 63, wave = tid >> 6;
    const int nwaves = gridDim.x * 8;
    for (int gw = blockIdx.x * 8 + wave; gw < MTOK / 8; gw += nwaves) {
        const int b = gw >> 8;
        f32x4 g4[4], b4[4];
#pragma unroll
        for (int i = 0; i < 4; ++i) { g4[i] = *(const f32x4*)(gam + 4 * lane + 256 * i); b4[i] = *(const f32x4*)(bet + 4 * lane + 256 * i); }
        for (int rr = 0; rr < 8; ++rr) {
            const size_t row = (size_t)gw * 8 + rr;
            const float* xp = X + row * D + 4 * lane;
            f32x4 v[4];
#pragma unroll
            for (int i = 0; i < 4; ++i) v[i] = *(const f32x4*)(xp + 256 * i);
            float s = 0.f;
#pragma unroll
            for (int i = 0; i < 4; ++i) s += (v[i][0] + v[i][1]) + (v[i][2] + v[i][3]);
            s = wave_sum(s);
            const float mean = s * (1.0f / 1024.0f);
            float q = 0.f;
#pragma unroll
            for (int i = 0; i < 4; ++i) { v[i] = v[i] - mean; q += (v[i][0] * v[i][0] + v[i][1] * v[i][1]) + (v[i][2] * v[i][2] + v[i][3] * v[i][3]); }
            q = wave_sum(q);
            const float rstd = 1.0f / sqrtf(q * (1.0f / 1024.0f) + LN_EPS);
#pragma unroll
            for (int i = 0; i < 4; ++i) { v[i] = v[i] * rstd * g4[i] + b4[i]; *(f32x4*)(XO + row * D + 4 * lane + 256 * i) = v[i]; }
            if (modn) {
#pragma unroll
                for (int i = 0; i < 4; ++i) {
                    const f32x4 sh = *(const f32x4*)(modn + (size_t)b * 9216 + 4 * lane + 256 * i), sc = *(const f32x4*)(modn + (size_t)b * 9216 + 1024 + 4 * lane + 256 * i);
                    const f32x4 h = v[i] * (sc + 1.0f) + sh;
                    u32x2 w; w.x = cvt_pk_bf16(h[0], h[1]); w.y = cvt_pk_bf16(h[2], h[3]);
                    *(u32x2*)(H + row * D + 4 * lane + 256 * i) = w;
                }
            }
            if (mkv) {
#pragma unroll
                for (int i = 0; i < 4; ++i) {
                    const f32x4 sh = *(const f32x4*)(mkv + (size_t)b * 2048 + 4 * lane + 256 * i), sc = *(const f32x4*)(mkv + (size_t)b * 2048 + 1024 + 4 * lane + 256 * i);
                    const f32x4 h = v[i] * (sc + 1.0f) + sh;
                    u32x2 w; w.x = cvt_pk_bf16(h[0], h[1]); w.y = cvt_pk_bf16(h[2], h[3]);
                    *(u32x2*)(HKV + row * D + 4 * lane + 256 * i) = w;
                }
            }
        }
    }
}

constexpr int SP_PITCH = 272;
__device__ void spatial_phase(LAS unsigned char* lds, const bf16_t* wsb  , const bf16_t* VT  , const float* vstat  ,
                              const float* lng, const float* lnb  , const float* bs  , const bf16_t* U  , bf16_t* UO) {
    const int tid = opaque_tid(), lane = tid & 63, wave = __builtin_amdgcn_readfirstlane(tid >> 6), r = lane & 15, q = lane >> 4;
    LAS unsigned char* WSL = lds;
    LAS unsigned char* VTL = lds + 128 * SP_PITCH;
    const int g = blockIdx.x & 7;
    const int s8 = tid & 15, clb = tid >> 4;
    if ((int)blockIdx.x >= 1024) return;
#pragma unroll
    for (int i = 0; i < 4; ++i) {
        const int pidx = tid + 512 * i, row = pidx >> 4, c16 = pidx & 15;
        const u32x4 w = *(const u32x4*)(wsb + (size_t)g * 16384 + row * 128 + c16 * 8);
        *(LAS u32x4*)(WSL + row * SP_PITCH + c16 * 16) = w;
    }
    LAS f32x2* GB = (LAS f32x2*)(lds + 384 * SP_PITCH);
    if (tid < 256) GB[tid] = (f32x2){lng[g * 256 + tid], lnb[g * 256 + tid]};
    LAS f32x2* MUS = (LAS f32x2*)(lds + 384 * SP_PITCH + 2048);
    for (int e = tid; e < 8 * 128; e += NTHREADS) {
        const int ui = e >> 7, tk = e & 127, unit_e = (int)blockIdx.x + (int)gridDim.x * ui;
        if (unit_e < 1024) {
            const size_t tok = (size_t)(unit_e >> 3) * 128 + tk;
            float s = 0.f, qq = 0.f;
#pragma unroll
            for (int pz = 0; pz < 16; ++pz) { const f32x2 pr = *(const f32x2*)(vstat + ((size_t)pz * MTOK + tok) * 2); s += pr.x; qq += pr.y; }
            const float mu = s * (1.0f / 2048.0f);
            MUS[e] = (f32x2){mu, 1.0f / sqrtf(fmaxf(qq * (1.0f / 2048.0f) - mu * mu, 0.f) + LN_EPS)};
        }
    }
    __syncthreads();
    float bst[8];
#pragma unroll
    for (int tt = 0; tt < 8; ++tt) bst[tt] = bs[g * 128 + 16 * tt + r];
    u32x4 vreg[8];
#define SP_LOAD(unit) do { const size_t _tok0 = (size_t)((unit) >> 3) * 128; \
        _Pragma("unroll") for (int i = 0; i < 8; ++i) vreg[i] = *(const u32x4*)(VT + (size_t)(g * 256 + clb + 32 * i) * MTOK + _tok0 + s8 * 8); } while (0)
    SP_LOAD(blockIdx.x);
    for (int unit = blockIdx.x; unit < 1024; unit += gridDim.x) {
        const size_t tok0 = (size_t)(unit >> 3) * 128;
        {
            float mu8[8], rs8[8];
            const int uidx = (unit - (int)blockIdx.x) / (int)gridDim.x;
#pragma unroll
            for (int j = 0; j < 8; ++j) { const f32x2 mr = MUS[uidx * 128 + s8 * 8 + j]; mu8[j] = mr.x; rs8[j] = mr.y; }
#pragma unroll
            for (int i = 0; i < 8; ++i) {
                const u32x4 w = vreg[i];
                const f32x2 gb = GB[clb + 32 * i];
                float f[8];
                f[0] = bf16_lo(w.x); f[1] = bf16_hi(w.x); f[2] = bf16_lo(w.y); f[3] = bf16_hi(w.y); f[4] = bf16_lo(w.z); f[5] = bf16_hi(w.z); f[6] = bf16_lo(w.w); f[7] = bf16_hi(w.w);
#pragma unroll
                for (int j = 0; j < 8; ++j) f[j] = (f[j] - mu8[j]) * rs8[j] * gb.x + gb.y;
                u32x4 o; o.x = cvt_pk_bf16(f[0], f[1]); o.y = cvt_pk_bf16(f[2], f[3]); o.z = cvt_pk_bf16(f[4], f[5]); o.w = cvt_pk_bf16(f[6], f[7]);
                *(LAS u32x4*)(VTL + (clb + 32 * i) * SP_PITCH + s8 * 16) = o;
            }
        }
        __syncthreads();
        u32x4 uw[8];
#pragma unroll
        for (int tt = 0; tt < 8; ++tt) uw[tt] = *(const u32x4*)(U + (tok0 + 16 * tt + r) * GH + g * 256 + 32 * wave + 8 * q);
        if (unit + (int)gridDim.x < 1024) SP_LOAD(unit + (int)gridDim.x);
#pragma unroll
        for (int th = 0; th < 2; ++th) {
            f32x4 acc[4][2];
#pragma unroll
            for (int t4 = 0; t4 < 4; ++t4)
#pragma unroll
                for (int cf = 0; cf < 2; ++cf) acc[t4][cf] = (f32x4){0.f, 0.f, 0.f, 0.f};
#pragma unroll
            for (int kk = 0; kk < (th == 0 ? 2 : 4); ++kk) {
                bf16x8 xf[2], yf[4];
#pragma unroll
                for (int cf = 0; cf < 2; ++cf) xf[cf] = *(const LAS bf16x8*)(VTL + (32 * wave + 8 * (r >> 2) + 4 * cf + (r & 3)) * SP_PITCH + (32 * kk + 8 * q) * 2);
#pragma unroll
                for (int t4 = 0; t4 < 4; ++t4) yf[t4] = *(const LAS bf16x8*)(WSL + (16 * (4 * th + t4) + r) * SP_PITCH + (32 * kk + 8 * q) * 2);
#pragma unroll
                for (int t4 = 0; t4 < 4; ++t4)
#pragma unroll
                    for (int cf = 0; cf < 2; ++cf) acc[t4][cf] = __builtin_amdgcn_mfma_f32_16x16x32_bf16(xf[cf], yf[t4], acc[t4][cf], 0, 0, 0);
            }
#pragma unroll
            for (int t4 = 0; t4 < 4; ++t4) {
                const int tt = 4 * th + t4;
                const size_t uoff = (tok0 + 16 * tt + r) * GH + g * 256 + 32 * wave + 8 * q;
                const f32x4 s0 = acc[t4][0] + bst[tt], s1 = acc[t4][1] + bst[tt];
                u32x4 o;
                o.x = cvt_pk_bf16(bf16_lo(uw[tt].x) * s0[0], bf16_hi(uw[tt].x) * s0[1]); o.y = cvt_pk_bf16(bf16_lo(uw[tt].y) * s0[2], bf16_hi(uw[tt].y) * s0[3]);
                o.z = cvt_pk_bf16(bf16_lo(uw[tt].z) * s1[0], bf16_hi(uw[tt].z) * s1[1]); o.w = cvt_pk_bf16(bf16_lo(uw[tt].w) * s1[2], bf16_hi(uw[tt].w) * s1[3]);
                *(u32x4*)(UO + uoff) = o;
            }
        }
        __syncthreads();
    }
#undef SP_LOAD
}

struct AttnState { float m; f32x4 O[4]; f32x4 L; };
__device__ __forceinline__ void attn_step2(AttnState& st, const bf16x8 (&qf)[2], const bf16x8 ones, LAS unsigned char* BUF, LAS float* TBL, int n, int kcA, bool vA, bool vB, int t, int r, int q) {
    f32x4 S[8];
    bf16x8 kf[8][2];
#pragma unroll
    for (int hf = 0; hf < 2; ++hf) {
        if (hf == 0 ? vA : vB) {
            LAS unsigned char* KL = BUF + hf * 16384;
            const int kc = kcA + hf;
            const int far = (n - kc >= 5) ? 1 : 0;
            const int m0 = far ? 0 : 319 - ((n - kc) * 64 + t - 4 * q);
#pragma unroll
            for (int j = 0; j < 4; ++j) {
                const int key = 16 * j + r;
                kf[4 * hf + j][0] = *(const LAS bf16x8*)(KL + key * 128 + ((q ^ (key & 7)) << 4));
                kf[4 * hf + j][1] = *(const LAS bf16x8*)(KL + key * 128 + (((4 + q) ^ (key & 7)) << 4));
                const int mj = far ? 0 : m0 + 16 * j;
                S[4 * hf + j] = *(const LAS f32x4*)(TBL + ((mj & 3) * 100 + (mj >> 2)) * 4);
            }
        }
    }
    float mx = st.m;
#pragma unroll
    for (int hf = 0; hf < 2; ++hf) {
        if (hf == 0 ? vA : vB) {
            __builtin_amdgcn_s_setprio(1);
#pragma unroll
            for (int j = 0; j < 4; ++j) {
                f32x4 sv = S[4 * hf + j];
                sv = __builtin_amdgcn_mfma_f32_16x16x32_bf16(kf[4 * hf + j][0], qf[0], sv, 0, 0, 0);
                sv = __builtin_amdgcn_mfma_f32_16x16x32_bf16(kf[4 * hf + j][1], qf[1], sv, 0, 0, 0);
                S[4 * hf + j] = sv;
            }
            __builtin_amdgcn_s_setprio(0);
        }
    }
    bf16x8 vf[2][2][4];
#pragma unroll
    for (int hf = 0; hf < 2; ++hf) {
        if (hf == 0 ? vA : vB) {
            LAS unsigned char* VL = BUF + hf * 16384 + 8192;
#pragma unroll
            for (int kb = 0; kb < 2; ++kb)
#pragma unroll
                for (int df = 0; df < 4; ++df) { const int d = 16 * df + r; vf[hf][kb][df] = *(const LAS bf16x8*)(VL + d * 128 + (((4 * kb + q) ^ (d & 7)) << 4)); }
        }
    }
#pragma unroll
    for (int hf = 0; hf < 2; ++hf) {
        if (hf == 0 ? vA : vB) {
#pragma unroll
            for (int j = 0; j < 4; ++j) { mx = fmaxf(fmaxf(mx, S[4 * hf + j][0]), S[4 * hf + j][1]); mx = fmaxf(fmaxf(mx, S[4 * hf + j][2]), S[4 * hf + j][3]); }
        }
    }
    mx = xmax32(xmax16(mx));
    const float alpha = __builtin_amdgcn_exp2f(st.m - mx);
    st.m = mx; st.L = st.L * alpha;
#pragma unroll
    for (int df = 0; df < 4; ++df) st.O[df] = st.O[df] * alpha;
#pragma unroll
    for (int hf = 0; hf < 2; ++hf) {
        if (hf == 0 ? vA : vB) {
#pragma unroll
            for (int j = 0; j < 4; ++j)
#pragma unroll
                for (int jj = 0; jj < 4; ++jj) S[4 * hf + j][jj] = __builtin_amdgcn_exp2f(S[4 * hf + j][jj] - mx);
#pragma unroll
            for (int kb = 0; kb < 2; ++kb) {
                const f32x4 p0 = S[4 * hf + 2 * kb], p1 = S[4 * hf + 2 * kb + 1];
                u32x4 pw; pw.x = cvt_pk_bf16(p0[0], p0[1]); pw.y = cvt_pk_bf16(p0[2], p0[3]); pw.z = cvt_pk_bf16(p1[0], p1[1]); pw.w = cvt_pk_bf16(p1[2], p1[3]);
                const bf16x8 pf = __builtin_bit_cast(bf16x8, pw);
                __builtin_amdgcn_s_setprio(1);
#pragma unroll
                for (int df = 0; df < 4; ++df) st.O[df] = __builtin_amdgcn_mfma_f32_16x16x32_bf16(vf[hf][kb][df], pf, st.O[df], 0, 0, 0);
                st.L = __builtin_amdgcn_mfma_f32_16x16x32_bf16(ones, pf, st.L, 0, 0, 0);
                __builtin_amdgcn_s_setprio(0);
            }
        }
    }
}
__device__ void attn_phase(LAS unsigned char* lds, const bf16_t* Q, bf16_t* AO, const bf16_t* KB, const bf16_t* VTB, const float* relb) {
    const int tid = opaque_tid(), lane = tid & 63, wave = __builtin_amdgcn_readfirstlane(tid >> 6), r = lane & 15, q = lane >> 4;
    const int qc = wave >> 2, qg = wave & 3;
    const int bx = blockIdx.x, G = gridDim.x;
    LAS float* TBL = (LAS float*)(lds + 65536);
    const int srow = tid >> 3, sc16 = tid & 7;
    const int kwoff = srow * 128 + ((sc16 ^ (srow & 7)) << 4);
    const int vg0 = 2 * sc16, vp0 = (vg0 & 8) + ((vg0 & 3) << 1) + ((vg0 >> 2) & 1), vp1 = (vg0 & 8) + (((vg0 + 1) & 3) << 1) + (((vg0 + 1) >> 2) & 1);
    const int vwoff0 = 8192 + srow * 128 + ((((vp0 >> 1) ^ (srow & 7)) << 4) | ((vp0 & 1) << 3));
    const int vwoff1 = 8192 + srow * 128 + ((((vp1 >> 1) ^ (srow & 7)) << 4) | ((vp1 & 1) << 3));
    bf16x8 ones;
#pragma unroll
    for (int x = 0; x < 8; ++x) ones[x] = (r == 0) ? (short)0x3F80 : (short)0;
    constexpr float LOG2E = 1.4426950408889634f;
    const int h = bx & 15, b = (bx >> 4) & 7;
    const int nun = (2048 - bx + G - 1) / G;
    if (nun <= 0) return;
    if (tid < 400) {
        const int s4 = tid / 100, k4 = tid - s4 * 100;
        f32x4 e;
#pragma unroll
        for (int x = 0; x < 4; ++x) { int dist = 319 - (4 * k4 + s4 + x); dist = dist < -63 ? -63 : (dist > 256 ? 256 : dist); e[x] = relb[h * 320 + dist + 63] * LOG2E; }
        *(LAS f32x4*)(TBL + tid * 4) = e;
    }
    const int t = 16 * qg + r;
    const bf16_t* kg = KB + ((size_t)b * SEQ + srow) * D + h * 64 + sc16 * 8;
    const bf16_t* vg = VTB + (size_t)(h * 64 + srow) * MTOK + (size_t)b * SEQ + sc16 * 8;
    const bf16_t* qg_p = Q + ((size_t)b * SEQ + (size_t)qc * 64 + t) * D + h * 64 + 8 * q;
#define U_NP(i) ((bx + G * (i)) >> 7)
#define U_P0(i) (U_NP(i) < 4 ? 4 - U_NP(i) : 0)
#define ATT_LOAD(R, i, p) do { const long _ko = (long)(2 * U_NP(i) - 8 + 2 * (p)) * 64; R##k0 = *(const u32x4*)(kg + _ko * D); R##v0 = *(const u32x4*)(vg + _ko); \
                               R##k1 = *(const u32x4*)(kg + (_ko + 64) * D); R##v1 = *(const u32x4*)(vg + _ko + 64); } while (0)
#define ATT_LOADQ(dst, i) do { const bf16_t* _qp = qg_p + (size_t)U_NP(i) * 128 * D; dst[0] = *(const bf16x8*)_qp; dst[1] = *(const bf16x8*)(_qp + 32); } while (0)
#define ATT_WRITE(R, bo) do { *(LAS u32x4*)(lds + (bo) + kwoff) = R##k0; *(LAS u32x2*)(lds + (bo) + vwoff0) = (u32x2){R##v0.x, R##v0.y}; *(LAS u32x2*)(lds + (bo) + vwoff1) = (u32x2){R##v0.z, R##v0.w}; \
                              *(LAS u32x4*)(lds + (bo) + 16384 + kwoff) = R##k1; *(LAS u32x2*)(lds + (bo) + 16384 + vwoff0) = (u32x2){R##v1.x, R##v1.y}; *(LAS u32x2*)(lds + (bo) + 16384 + vwoff1) = (u32x2){R##v1.z, R##v1.w}; } while (0)
#define ATT_ADV(i, p) do { if (++(p) > 4) { ++(i); (p) = ((i) < nun) ? U_P0(i) : 0; } } while (0)
#define ATT_ITER(X, Y, bc, bn) do { \
        if (ci > 0 && cp == U_P0(ci)) { qf[0] = qn[0]; qf[1] = qn[1]; st.m = -3.0e38f; st.L = (f32x4){0.f, 0.f, 0.f, 0.f}; _Pragma("unroll") for (int df = 0; df < 4; ++df) st.O[df] = (f32x4){0.f, 0.f, 0.f, 0.f}; } \
        if (li < nun) { ATT_LOAD(X, li, lp); if (lp == U_P0(li)) ATT_LOADQ(qn, li); ATT_ADV(li, lp); } \
        { const int _np = U_NP(ci), _n = 2 * _np + qc, _kc = 2 * _np - 8 + 2 * cp; const bool _va = (_kc >= _n - 8 && _kc <= _n), _vb = (_kc + 1 >= _n - 8 && _kc + 1 <= _n); \
          if (_va || _vb) attn_step2(st, qf, ones, lds + (bc), TBL, _n, _kc, _va, _vb, t, r, q); \
          if (cp == 4) { const float inv = 1.0f / __shfl(st.L[0], r); bf16_t* op = AO + ((size_t)b * SEQ + (size_t)_n * 64 + t) * D + h * 64 + 4 * q; \
            _Pragma("unroll") for (int df = 0; df < 4; ++df) { u32x2 o; o.x = cvt_pk_bf16(st.O[df][0] * inv, st.O[df][1] * inv); o.y = cvt_pk_bf16(st.O[df][2] * inv, st.O[df][3] * inv); *(u32x2*)(op + 16 * df) = o; } } } \
        ++g; \
        if (g < total) ATT_WRITE(Y, bn); \
        __syncthreads(); \
        ATT_ADV(ci, cp); \
    } while (0)
    int total = 0;
    for (int i = 0; i < nun; ++i) total += 5 - U_P0(i);
    int li = 0, lp = U_P0(0), ci = 0, cp = lp, g = 0;
    const u32x4 z4 = (u32x4){0u, 0u, 0u, 0u};
    u32x4 Ak0, Av0, Ak1, Av1, Bk0 = z4, Bv0 = z4, Bk1 = z4, Bv1 = z4;
    bf16x8 qf[2], qn[2];
    qn[0] = qn[1] = ones;
    AttnState st; st.m = -3.0e38f; st.L = (f32x4){0.f, 0.f, 0.f, 0.f};
#pragma unroll
    for (int df = 0; df < 4; ++df) st.O[df] = (f32x4){0.f, 0.f, 0.f, 0.f};
    ATT_LOAD(A, li, lp); ATT_LOADQ(qf, 0); ATT_ADV(li, lp);
    if (li < nun) { ATT_LOAD(B, li, lp); if (lp == U_P0(li)) ATT_LOADQ(qn, li); ATT_ADV(li, lp); }
    ATT_WRITE(A, 0);
    __syncthreads();
    for (;;) {
        ATT_ITER(A, B, 0, 32768);
        if (g >= total) break;
        ATT_ITER(B, A, 32768, 0);
        if (g >= total) break;
    }
#undef U_NP
#undef U_P0
#undef ATT_LOAD
#undef ATT_LOADQ
#undef ATT_WRITE
#undef ATT_ADV
#undef ATT_ITER
}

#define P_X ((float*)(WSP() + WS_X))
#define P_H ((bf16_t*)(WSP() + WS_H))
#define P_ACT ((bf16_t*)(WSP() + WS_ACT))
#define P_VT ((bf16_t*)(WSP() + WS_VT))
#define P_HKV ((bf16_t*)(WSP() + WS_VT))
#define P_KB ((bf16_t*)(WSP() + WS_KB))
#define P_VTB ((bf16_t*)(WSP() + WS_VTB))
#define P_MOD ((const float*)(WSP() + WS_MOD))
#define P_MKV ((const float*)(WSP() + WS_MKV))
#define P_W(off) ((const bf16_t*)(WSP() + (off)))
__global__ void __launch_bounds__(NTHREADS) fwd_megakernel(Params p) {
    extern __shared__ __attribute__((aligned(16))) unsigned char lds_raw[];
    LAS unsigned char* lds = (LAS unsigned char*)lds_raw;
    cg::grid_group grid = cg::this_grid();
    const int G = gridDim.x, bx = blockIdx.x;

    volatile LAS unsigned* bst = (volatile LAS unsigned*)(lds + LDS_STAGE);
    if (threadIdx.x < 4) bst[threadIdx.x] = 0u;
    __syncthreads();
#define GRID_BAR() do { XcdBarrier _b; _b.bar = (unsigned*)(WSP() + WS_BAR); _b.x = xb_xcc_id(); _b.st = bst; xcd_barrier(_b); } while (0)
    xcd_barrier_post((unsigned*)(WSP() + WS_BAR));
    if (gridDim.x == 0x7fffffffu) grid.sync();
    p0_phase(lds);
    GRID_BAR();
    p0b_phase();
    GRID_BAR();

#pragma unroll 1
    for (int sub = 0; sub < 12; ++sub) {
        const int l = sub / 3, i = sub - 3 * l;
        if (i != 1) {
            const int s = i >> 1;
            pg8::Gemm g{P_H, P_W(WS_WGU) + (size_t)(l * 2 + s) * 5632 * 1024, MTOK, 5632, D};
            pg8::StaticOrder S; S.init(MTOK, 5632, G, bx);
            EpiSwiglu E{P_ACT};
            pg8::gemm_phase<EpiSwiglu, true, true>(lds, g, S, E);
            if (bx >= 128 && sub < 10) {
                int ja, jb, jc = -1, jd = -1;
                if (sub == 0) { ja = 1; jb = 9; }
                else if (sub == 2) { ja = 2; jb = 10; jc = 17; }
                else if (sub == 3) { ja = 3; jb = 11; jc = 19; }
                else if (sub == 5) { ja = 4; jb = 12; jc = 20; }
                else if (sub == 6) { ja = 5; jb = 13; jc = 21; jd = 23; }
                else if (sub == 8) { ja = 6; jb = 14; jc = 22; jd = 24; }
                else { ja = 7; jb = 15; }
                conv_multi(lds, ja, jb, jc, jd, bx - 128, 128);
            }
        } else if (l < 2) {
            {
                pg8::Gemm g{P_H, P_W(WS_WIN) + (size_t)l * 4096 * 1024, MTOK, GH, D};
                pg8::StaticOrder S; S.init(MTOK, GH, G, bx);
                EpiBf16<1, true, false> E{P_ACT, GH, IN(9) + l * 4096, 1.0f, nullptr};
                pg8::gemm_phase<EpiBf16<1, true, false>, true, true>(lds, g, S, E);
            }
            {
                pg8::Gemm g{P_W(WS_WIN) + (size_t)l * 4096 * 1024 + (size_t)2048 * 1024, P_H, GH, MTOK, D};
                pg8::StaticOrder S; S.init(GH, MTOK, G, bx);
                EpiBf16<2, true, true> E{P_VT, MTOK, IN(9) + l * 4096 + 2048, 1.0f, (float*)(WSP() + WS_VPART) + (size_t)l * 16 * MTOK * 2};
                pg8::gemm_phase<EpiBf16<2, true, true>, true, true>(lds, g, S, E);
            }
            GRID_BAR();
            spatial_phase(lds, P_W(WS_WSB) + (size_t)l * 8 * 16384, P_VT, (const float*)(WSP() + WS_VPART) + (size_t)l * 16 * MTOK * 2,
                          IN(10) + l * GH, IN(11) + l * GH, IN(13) + l * 8 * 128, P_ACT, P_ACT);
        } else {
            const int j = l - 2;
            {
                pg8::Gemm g{P_H, P_W(WS_WQ) + (size_t)j * 1024 * 1024, MTOK, D, D};
                pg8::StaticOrder S; S.init(MTOK, D, G, bx);
                EpiBf16<0, false, false> E{P_ACT, D, nullptr, 0.125f * 1.4426950408889634f, nullptr};
                pg8::gemm_phase<EpiBf16<0, false, false>, true, true>(lds, g, S, E);
            }
            GRID_BAR();
            attn_phase(lds, P_ACT, P_ACT, P_KB, P_VTB, IN(19) + j * 16 * 320);
        }
        GRID_BAR();
        {
            const bf16_t* rB; int rK; float coef;
            if (i != 1) { rB = P_W(WS_WDOWN) + (size_t)(l * 2 + (i >> 1)) * 1024 * 2816; rK = DFF; coef = 0.5f; }
            else if (l < 2) { rB = P_W(WS_WOUT) + (size_t)l * 1024 * 2048; rK = GH; coef = 1.0f; }
            else { rB = P_W(WS_WO) + (size_t)(l - 2) * 1024 * 1024; rK = D; coef = 1.0f; }
            const bool last = (sub == 11);
            const int l2 = (i == 2) ? l + 1 : l, i2 = (i == 2) ? 0 : i + 1;
            const float* modn = last ? nullptr : P_MOD + (size_t)l2 * 8 * 9216 + (3 * i2) * 1024;
            pg8::Gemm g{P_ACT, rB, MTOK, D, rK};
            pg8::StaticOrder S; S.init(MTOK, D, G, bx);
            void* X = (void*)P_X;
            EpiResidLn E{(const void*)X, last ? (void*)OUTP() : X, P_MOD + (size_t)l * 8 * 9216 + (3 * i + 2) * 1024, IN(4) + (l * 3 + i) * D, IN(5) + (l * 3 + i) * D,
                         modn, P_H, (sub == 5) ? P_MKV : nullptr, P_HKV,
                         PanelStats{(unsigned long long*)(WSP() + WS_XBUF), (unsigned*)(WSP() + WS_CNT) + (size_t)sub * 64 * 64}, coef, last ? 1 : 0};
            pg8::gemm_phase<EpiResidLn, false, true>(lds, g, S, E);
        }
        if (sub == 11) break;
        GRID_BAR();
        if (sub == 5) {
            {
                pg8::Gemm g{P_HKV, P_W(WS_WKV), MTOK, D, D};
                pg8::StaticOrder S; S.init(MTOK, D, G, bx);
                EpiBf16<0, false, false> E{P_KB, D, nullptr, 1.0f, nullptr};
                pg8::gemm_phase<EpiBf16<0, false, false>, true, true>(lds, g, S, E);
            }
            {
                pg8::Gemm g{P_W(WS_WKV) + (size_t)1024 * 1024, P_HKV, D, MTOK, D};
                pg8::StaticOrder S; S.init(D, MTOK, G, bx);
                EpiBf16<0, false, false> E{P_VTB, MTOK, nullptr, 1.0f, nullptr};
                pg8::gemm_phase<EpiBf16<0, false, false>, true, true>(lds, g, S, E);
            }
        }
    }
}

extern "C" void kernel_launch(void* const* d_in, const int* in_sizes, int n_in, void* d_out, int out_size, void* d_ws, size_t ws_size, hipStream_t stream) {
    static int grid_blocks = 0;
    if (grid_blocks == 0) {
        if (n_in != 21 || ws_size < WS_END) { fprintf(stderr, "kernel_launch: expected 21 inputs and >= %zu bytes of workspace (got %d, %zu)\n", (size_t)WS_END, n_in, ws_size); grid_blocks = -1; return; }
        int dev = 0, cus = 0, per_cu = 0;
        hipGetDevice(&dev);
        hipDeviceGetAttribute(&cus, hipDeviceAttributeMultiprocessorCount, dev);
        if (hipFuncSetAttribute((const void*)fwd_megakernel, hipFuncAttributeMaxDynamicSharedMemorySize, LDS_BYTES) != hipSuccess) { fprintf(stderr, "kernel_launch: hipFuncSetAttribute failed\n"); grid_blocks = -1; return; }
        hipOccupancyMaxActiveBlocksPerMultiprocessor(&per_cu, (const void*)fwd_megakernel, NTHREADS, LDS_BYTES);
        if (per_cu < 1) { fprintf(stderr, "kernel_launch: occupancy query says %d blocks per CU\n", per_cu); per_cu = 1; }
        (void)hipGetLastError();
        grid_blocks = 256;
        if (cus < 256) { fprintf(stderr, "kernel_launch: this kernel needs 256 CUs (device has %d)\n", cus); grid_blocks = -1; return; }
    }
    if (grid_blocks < 0) return;
    Params p{};
    for (int i = 0; i < 21; ++i) p.in[i] = (const float*)d_in[i];
    p.out = (float*)d_out; p.ws = (unsigned char*)d_ws;
    if (hipMemsetAsync((unsigned char*)d_ws + WS_BAR, 0, WS_ZERO_END - WS_BAR, stream) != hipSuccess) { fprintf(stderr, "kernel_launch: hipMemsetAsync failed\n"); return; }
    void* args[] = {&p};
    hipError_t e = hipLaunchCooperativeKernel((const void*)fwd_megakernel, dim3(grid_blocks), dim3(NTHREADS), args, LDS_BYTES, stream);
    if (e != hipSuccess) fprintf(stderr, "cooperative launch failed: %s (grid %d)\n", hipGetErrorString(e), grid_blocks);
}
```

```cpp
#include <hip/hip_runtime.h>
#include <hip/hip_cooperative_groups.h>
#include <cstdio>
namespace cg = cooperative_groups;

#define LAS __attribute__((address_space(3)))
typedef unsigned short bf16_t;
typedef short bf16x8 __attribute__((ext_vector_type(8)));
typedef float f32x4 __attribute__((ext_vector_type(4)));
typedef float f32x2 __attribute__((ext_vector_type(2)));
typedef unsigned u32x4 __attribute__((ext_vector_type(4)));
typedef unsigned u32x2 __attribute__((ext_vector_type(2)));
typedef _Float16 h16x4 __attribute__((ext_vector_type(4)));
typedef _Float16 h16x8 __attribute__((ext_vector_type(8)));

constexpr int D = 1024, NB = 8, SEQ = 2048, MTOK = NB * SEQ, DFF = 2816, GH = 2048, NMOD = 9;
constexpr float ALPHA = 1.6817928305074290f;
constexpr float LN_EPS = 1e-5f;

constexpr size_t WS_WGU = 0;
constexpr size_t WS_WDOWN = WS_WGU + 8ull * 5632 * 1024 * 2;
constexpr size_t WS_WIN = WS_WDOWN + 8ull * 1024 * 2816 * 2;
constexpr size_t WS_WOUT = WS_WIN + 2ull * 4096 * 1024 * 2;
constexpr size_t WS_WKV = WS_WOUT + 2ull * 1024 * 2048 * 2;
constexpr size_t WS_WQ = WS_WKV + 2048ull * 1024 * 2;
constexpr size_t WS_WO = WS_WQ + 2ull * 1024 * 1024 * 2;
constexpr size_t WS_WSB = WS_WO + 2ull * 1024 * 1024 * 2;
constexpr size_t WS_X = WS_WSB + 2ull * 8 * 128 * 128 * 2;
constexpr size_t WS_H = WS_X + (size_t)MTOK * D * 4;
constexpr size_t WS_ACT = WS_H + (size_t)MTOK * D * 2;
constexpr size_t WS_VT = WS_ACT + (size_t)MTOK * DFF * 2;
constexpr size_t WS_KB = WS_VT + (size_t)GH * MTOK * 2;
constexpr size_t WS_VTB = WS_KB + (size_t)MTOK * D * 2;
constexpr size_t WS_MOD = WS_VTB + (size_t)MTOK * D * 2;
constexpr size_t WS_MKV = WS_MOD + 4ull * 8 * 9216 * 4;
constexpr size_t WS_VSTAT = WS_MKV + 8ull * 2048 * 4;
constexpr size_t WS_BAR = WS_VSTAT + 2ull * MTOK * 2 * 4;
constexpr size_t WS_CNT = WS_BAR + 16384;
constexpr size_t WS_ZERO_END = WS_CNT + 12ull * 64 * 256;
constexpr size_t WS_XBUF = WS_ZERO_END;
constexpr size_t WS_VPART = WS_XBUF + (size_t)MTOK * 4 * 8;
constexpr size_t WS_END = WS_VPART + 2ull * 16 * MTOK * 2 * 4;

constexpr int LDS_STAGE = 131072;
constexpr int LDS_BYTES = LDS_STAGE + 16;
constexpr int NTHREADS = 512;

struct Params {
    const float* in[21];
    float* out;
    unsigned char* ws;
};


#define AS4 __attribute__((address_space(4)))
__device__ __forceinline__ const unsigned char* karg(int byteoff) {
    const AS4 unsigned char* ka = (const AS4 unsigned char*)__builtin_amdgcn_kernarg_segment_ptr();
    asm volatile("" : "+s"(byteoff));
    return *(const unsigned char* const AS4*)(ka + byteoff);
}
#define IN(k) ((const float*)karg(8 * (k)))
#define OUTP() ((float*)karg(8 * 21))
#define WSP() ((unsigned char*)karg(8 * 22))

typedef __bf16 bf16v2_t __attribute__((ext_vector_type(2)));
__device__ __forceinline__ unsigned cvt_pk_bf16(float lo, float hi) { const f32x2 v = {lo, hi}; return __builtin_bit_cast(unsigned, __builtin_convertvector(v, bf16v2_t)); }
__device__ __forceinline__ float bf16_lo(unsigned w) { return __uint_as_float(w << 16); }
__device__ __forceinline__ float bf16_hi(unsigned w) { return __uint_as_float(w & 0xffff0000u); }
__device__ __forceinline__ float silu_f(float x) { return x * __builtin_amdgcn_rcpf(1.0f + __expf(-x)); }
__device__ __forceinline__ f32x2 swiglu_pk(f32x2 g, f32x2 u) {
    const f32x2 s = g * (-1.4426950408889634f);
    f32x2 e; e.x = __builtin_amdgcn_exp2f(s.x); e.y = __builtin_amdgcn_exp2f(s.y);
    const f32x2 d = e + 1.0f;
    f32x2 rc; rc.x = __builtin_amdgcn_rcpf(d.x); rc.y = __builtin_amdgcn_rcpf(d.y);
    return (g * rc) * u;
}
__device__ __forceinline__ f32x4 swiglu4(f32x4 g, f32x4 u) { const f32x2 a = swiglu_pk((f32x2){g[0], g[1]}, (f32x2){u[0], u[1]}), b = swiglu_pk((f32x2){g[2], g[3]}, (f32x2){u[2], u[3]}); return (f32x4){a.x, a.y, b.x, b.y}; }
__device__ __forceinline__ f32x2 gelu_pk(f32x2 v) {
    const f32x2 av = __builtin_elementwise_abs(v), d = av * 0.2316418882f + 1.0f;
    f32x2 t; t.x = __builtin_amdgcn_rcpf(d.x); t.y = __builtin_amdgcn_rcpf(d.y);
    f32x2 q = t * 0.5307027145f + (-0.7265760135f); q = q * t + 0.7107068705f; q = q * t + (-0.142248368f); q = q * t + 0.127414796f; q = q * t;
    const f32x2 s = (v * v) * (-0.72134752044f);
    f32x2 e; e.x = __builtin_amdgcn_exp2f(s.x); e.y = __builtin_amdgcn_exp2f(s.y);
    const f32x2 m = v * (q * e), r = v - m;
    f32x2 o; o.x = v.x < 0.f ? m.x : r.x; o.y = v.y < 0.f ? m.y : r.y; return o;
}
__device__ __forceinline__ f32x4 gelu4(f32x4 v) { f32x2 a = gelu_pk((f32x2){v[0], v[1]}), b = gelu_pk((f32x2){v[2], v[3]}); return (f32x4){a.x, a.y, b.x, b.y}; }
__device__ __forceinline__ int opaque_tid() { int t = threadIdx.x; asm volatile("" : "+v"(t)); return t; }
__device__ __forceinline__ float dpp_sum16(float x) {
    x += __int_as_float(__builtin_amdgcn_update_dpp(0, __float_as_int(x), 0xB1, 0xF, 0xF, true));
    x += __int_as_float(__builtin_amdgcn_update_dpp(0, __float_as_int(x), 0x4E, 0xF, 0xF, true));
    x += __int_as_float(__builtin_amdgcn_update_dpp(0, __float_as_int(x), 0x141, 0xF, 0xF, true));
    x += __int_as_float(__builtin_amdgcn_update_dpp(0, __float_as_int(x), 0x140, 0xF, 0xF, true));
    return x;
}
__device__ __forceinline__ float xsum16(float x) { const auto r = __builtin_amdgcn_permlane16_swap(__float_as_uint(x), __float_as_uint(x), false, false); return __uint_as_float(r[0]) + __uint_as_float(r[1]); }
__device__ __forceinline__ float xsum32(float x) { const auto r = __builtin_amdgcn_permlane32_swap(__float_as_uint(x), __float_as_uint(x), false, false); return __uint_as_float(r[0]) + __uint_as_float(r[1]); }
__device__ __forceinline__ float xmax16(float x) { const auto r = __builtin_amdgcn_permlane16_swap(__float_as_uint(x), __float_as_uint(x), false, false); return fmaxf(__uint_as_float(r[0]), __uint_as_float(r[1])); }
__device__ __forceinline__ float xmax32(float x) { const auto r = __builtin_amdgcn_permlane32_swap(__float_as_uint(x), __float_as_uint(x), false, false); return fmaxf(__uint_as_float(r[0]), __uint_as_float(r[1])); }
__device__ __forceinline__ float wave_sum(float s) {
    s += __shfl_xor(s, 1); s += __shfl_xor(s, 2); s += __shfl_xor(s, 4); s += __shfl_xor(s, 8); s += __shfl_xor(s, 16); s += __shfl_xor(s, 32); return s;
}


#define XB_TMO      128
#define XB_XCNT(j)  (256  + 64 * (j))
#define XB_XSUB(j)  (1280 + 64 * (j))
#define XB_XGEN(j)  (2304 + 64 * (j))
#define XB_TOP      3328
#define XB_TOPGEN   3392
#define XCD_BAR_WORDS 3456
#define XB_SPIN_CAP (1u << 22)
__device__ __forceinline__ unsigned xb_ld(unsigned* p)              { return __hip_atomic_load(p, __ATOMIC_RELAXED, __HIP_MEMORY_SCOPE_AGENT); }
__device__ __forceinline__ unsigned xb_add(unsigned* p, unsigned v) { return __hip_atomic_fetch_add(p, v, __ATOMIC_RELAXED, __HIP_MEMORY_SCOPE_AGENT); }
__device__ __forceinline__ unsigned xb_xcc_id() { return (unsigned)__builtin_amdgcn_s_getreg((3 << 11) | 20) & 0xFu; }
#define XB_SPIN(cond, bar) do { unsigned _sp = 0; while (cond) { __builtin_amdgcn_s_sleep(1); \
    if ((++_sp & 255u) == 0u) { if (xb_ld(&(bar)[XB_TMO])) break; if (_sp > XB_SPIN_CAP) { atomicAdd(&(bar)[XB_TMO], 1u); break; } } } } while (0)
struct XcdBarrier { unsigned* bar; unsigned x; volatile LAS unsigned* st; };
__device__ __forceinline__ void xcd_barrier_post(unsigned* bar) { if (threadIdx.x == 0) (void)xb_add(&bar[XB_XCNT(xb_xcc_id())], 1u); }
__device__ __forceinline__ void xcd_barrier_complete(unsigned* bar, unsigned x, unsigned& nloc, unsigned& nx) {
    const unsigned G = gridDim.x * gridDim.y * gridDim.z;
    unsigned sum, cnt, mine, sp = 0u;
    for (;;) {
        sum = 0u; cnt = 0u; mine = 0u;
#pragma unroll
        for (unsigned j = 0; j < 16; ++j) { const unsigned c = xb_ld(&bar[XB_XCNT(j)]); sum += c; cnt += (c > 0u) ? 1u : 0u; mine = (j == x) ? c : mine; }
        if (sum == G) break;
        __builtin_amdgcn_s_sleep(1);
        if ((++sp & 255u) == 0u) { if (xb_ld(&bar[XB_TMO])) break; if (sp > XB_SPIN_CAP) { atomicAdd(&bar[XB_TMO], 1u); break; } }
    }
    nloc = mine > 0u ? mine : 1u; nx = cnt > 0u ? cnt : 1u;
}
__device__ __forceinline__ void xcd_barrier(const XcdBarrier& b) {
    asm volatile("s_waitcnt vmcnt(0)" ::: "memory");
    __syncthreads();
    if (threadIdx.x == 0) {
        unsigned* bar = b.bar;
        __builtin_amdgcn_s_waitcnt(0);
        unsigned nloc = b.st[0], nx = b.st[1];
        if (nloc == 0u) { xcd_barrier_complete(bar, b.x, nloc, nx); b.st[0] = nloc; b.st[1] = nx; }
        const unsigned old = xb_add(&bar[XB_XSUB(b.x)], 1u);
        const unsigned gen = old / nloc;
        if (old + 1u == (gen + 1u) * nloc) {
            __builtin_amdgcn_fence(__ATOMIC_RELEASE, "agent");
            asm volatile("s_waitcnt vmcnt(0)" ::: "memory");
            const unsigned og = xb_add(&bar[XB_TOP], 1u);
            const unsigned tg = og / nx;
            if (og + 1u == (tg + 1u) * nx) xb_add(&bar[XB_TOPGEN], 1u);
            else XB_SPIN(xb_ld(&bar[XB_TOPGEN]) == tg, bar);
            __builtin_amdgcn_fence(__ATOMIC_ACQUIRE, "agent");
            xb_add(&bar[XB_XGEN(b.x)], 1u);
            asm volatile("s_waitcnt vmcnt(0)" ::: "memory");
        } else {
            XB_SPIN(xb_ld(&bar[XB_XGEN(b.x)]) == gen, bar);
            __builtin_amdgcn_fence(__ATOMIC_ACQUIRE, "agent");
            asm volatile("s_waitcnt vmcnt(0)" ::: "memory");
        }
    }
    __syncthreads();
}

namespace pg8 {
constexpr int BM = 256, BK = 64, HALF = 128, HTB = HALF * BK * 2, STAGE_BYTES = 8 * HTB, NXCD = 8, WGM = 8;
__device__ __forceinline__ int lds_byte(int r, int c) { const int st = (r >> 4) * 2 + (c >> 5), rr = r & 15, cc = c & 31, ob = rr * 64 + cc * 2; return st * 1024 + (ob ^ (((ob >> 9) & 1) << 5)); }
__device__ __forceinline__ void stage_rc(int b, int& R, int& C) { const int st = b / 1024, sb = b % 1024, swz = sb ^ (((sb >> 9) & 1) << 5); R = (st >> 1) * 16 + swz / 64; C = (st & 1) * 32 + (swz % 64) / 2; }
__device__ __forceinline__ int perm32(int rho) { const int n = rho >> 4, i = rho & 15; return 8 * (i >> 2) + 4 * n + (i & 3); }

struct Unit { int pm, pn; };
struct Gemm { const bf16_t* A; const bf16_t* Bt; int M, N, K; };

struct StaticOrder {
    int nM, nN, nwg, G, c;
    __device__ void init(int M, int N, int G_, int c_) { nM = M / BM; nN = N / BM; nwg = nM * nN; G = G_; c = c_; }
    __device__ bool next(int i, Unit& u) const {
        const long L = (long)i * G + c; if (L >= nwg) return false;
        int wgid = (int)L; { const int q = nwg / NXCD, r = nwg % NXCD, xcd = wgid % NXCD, off = wgid / NXCD; wgid = (xcd < r ? xcd * (q + 1) : r * (q + 1) + (xcd - r) * q) + off; }
        const int nig = WGM * nN, gid = wgid / nig, fm = gid * WGM, gsz = (nM - fm) < WGM ? (nM - fm) : WGM;
        u.pm = fm + ((wgid % nig) % gsz); u.pn = (wgid % nig) / gsz; return true;
    }
};

template <class Epi, bool ALIGN_EPI = false, bool SP2 = false>
__device__ __forceinline__ void gemm_phase(LAS unsigned char* lds, const Gemm g, const StaticOrder S, const Epi E) {
    const int tid = opaque_tid(), wid = __builtin_amdgcn_readfirstlane(tid >> 6), lane = tid & 63, wr = wid >> 2, wc = wid & 3, fr = lane & 15, fq = lane >> 4;
    const int K = g.K, nt = K / BK;
    unsigned voffA[2], voffB[2];
#pragma unroll
    for (int i = 0; i < 2; ++i) { int R, C; stage_rc(tid * 16 + i * 8192, R, C); const int Rb = Epi::PERM ? ((R & ~31) + perm32(R & 31)) : R;
        voffA[i] = (unsigned)(R * K + C) * 2u; voffB[i] = (unsigned)(Rb * K + C) * 2u; }
    const size_t kstep = (size_t)(BK * 2);
    const size_t hstep = (size_t)HALF * K * 2;
    const size_t tstep = 2 * hstep;
    const unsigned ldsw = (unsigned)wid * 1024u;
    const int aoff = lds_byte(wr * 64 + fr, fq * 8), boff = lds_byte(wc * 32 + fr, fq * 8);
#define PG8_SA(b, h) (((b) * 2 + (h)) * HTB)
#define PG8_SB(b, h) ((4 + (b) * 2 + (h)) * HTB)
#define PG8_STAGE(bufoff, gbase, voff) do { _Pragma("unroll") for (int _i = 0; _i < 2; ++_i) \
        __builtin_amdgcn_global_load_lds((const unsigned*)((const char*)(gbase) + (voff)[_i]), (LAS unsigned*)(lds + (bufoff) + ldsw + _i * 8192), 16, 0, 0); } while (0)
#define PG8_LDA(dst, b, h) do { _Pragma("unroll") for (int m = 0; m < 4; ++m) _Pragma("unroll") for (int k = 0; k < 2; ++k) dst[m][k] = *(const LAS bf16x8*)(lds + PG8_SA(b, h) + aoff + m * 2048 + k * 1024); } while (0)
#define PG8_LDB(dst, b, h) do { _Pragma("unroll") for (int n = 0; n < 2; ++n) _Pragma("unroll") for (int k = 0; k < 2; ++k) dst[n][k] = *(const LAS bf16x8*)(lds + PG8_SB(b, h) + boff + n * 2048 + k * 1024); } while (0)
#define PG8_MMA(ai, bj, At, Bt) do { __builtin_amdgcn_s_setprio(1); _Pragma("unroll") for (int m = 0; m < 4; ++m) _Pragma("unroll") for (int n = 0; n < 2; ++n) _Pragma("unroll") for (int k = 0; k < 2; ++k) \
        acc[ai][bj][m][n] = __builtin_amdgcn_mfma_f32_16x16x32_bf16(Bt[n][k], At[m][k], acc[ai][bj][m][n], 0, 0, 0); __builtin_amdgcn_s_setprio(0); } while (0)
#define PG8_WAIT_V(n) asm volatile("s_waitcnt vmcnt(" #n ")" ::: "memory")
#define PG8_WAIT_L(n) asm volatile("s_waitcnt lgkmcnt(" #n ")" ::: "memory")
#define PG8_BAR __builtin_amdgcn_s_barrier()
#define PG8_SCHED __builtin_amdgcn_sched_barrier(0)
    Unit cur, nxt; int ui = 0;
    if (!S.next(0, cur)) return;
    f32x4 acc[2][2][4][2];
#pragma unroll
    for (int a = 0; a < 2; ++a)
#pragma unroll
        for (int b = 0; b < 2; ++b)
#pragma unroll
            for (int m = 0; m < 4; ++m)
#pragma unroll
                for (int n = 0; n < 2; ++n) acc[a][b][m][n] = (f32x4){0.f, 0.f, 0.f, 0.f};
    bf16x8 At[4][2], B0[2][2], B1[2][2];
    const char* cA = (const char*)g.A + (size_t)cur.pm * tstep; const char* cB = (const char*)g.Bt + (size_t)cur.pn * tstep;
    if (SP2) {
        PG8_STAGE(PG8_SB(0, 0), cB, voffB); PG8_STAGE(PG8_SB(0, 1), cB + hstep, voffB); PG8_STAGE(PG8_SA(0, 0), cA, voffA); PG8_STAGE(PG8_SA(0, 1), cA + hstep, voffA);
        if (wr == 1) PG8_BAR;
        PG8_WAIT_V(2); PG8_BAR;
        PG8_STAGE(PG8_SB(1, 0), cB + kstep, voffB); PG8_STAGE(PG8_SA(1, 0), cA + kstep, voffA); PG8_STAGE(PG8_SB(1, 1), cB + hstep + kstep, voffB);
        PG8_WAIT_V(6); PG8_BAR;
    } else {
        PG8_STAGE(PG8_SB(0, 0), cB, voffB); PG8_STAGE(PG8_SA(0, 0), cA, voffA); PG8_STAGE(PG8_SB(0, 1), cB + hstep, voffB); PG8_STAGE(PG8_SA(0, 1), cA + hstep, voffA);
        if (wr == 1) PG8_BAR;
        PG8_WAIT_V(4); PG8_BAR;
        PG8_STAGE(PG8_SB(1, 0), cB + kstep, voffB); PG8_STAGE(PG8_SA(1, 0), cA + kstep, voffA); PG8_STAGE(PG8_SB(1, 1), cB + hstep + kstep, voffB);
        PG8_WAIT_V(6); PG8_BAR;
    }
    for (;;) {
        const bool has_next = S.next(ui + 1, nxt);
        const char* nA = has_next ? (const char*)g.A + (size_t)nxt.pm * tstep : cA; const char* nB = has_next ? (const char*)g.Bt + (size_t)nxt.pn * tstep : cB;
        for (int t = 0; t < nt; t += 2) {
            const bool last = (t == nt - 2);
            const char* a1 = cA + (size_t)(t + 1) * kstep;
            const char* a2 = last ? nA : cA + (size_t)(t + 2) * kstep; const char* b2 = last ? nB : cB + (size_t)(t + 2) * kstep;
            const char* a3 = a2 + kstep; const char* b3 = b2 + kstep;
            if (SP2) {
            PG8_LDB(B0, 0, 0); PG8_LDB(B1, 0, 1); PG8_SCHED; PG8_LDA(At, 0, 0); PG8_STAGE(PG8_SA(1, 1), a1 + hstep, voffA);
            PG8_WAIT_V(8); PG8_WAIT_L(0); PG8_BAR; PG8_MMA(0, 0, At, B0); PG8_MMA(0, 1, At, B1); PG8_BAR; PG8_SCHED;
            PG8_LDA(At, 0, 1); PG8_STAGE(PG8_SB(0, 0), b2, voffB); PG8_STAGE(PG8_SB(0, 1), b2 + hstep, voffB); PG8_STAGE(PG8_SA(0, 0), a2, voffA);
            PG8_WAIT_V(8); PG8_WAIT_L(0); PG8_BAR; PG8_MMA(1, 0, At, B0); PG8_MMA(1, 1, At, B1); PG8_BAR; PG8_SCHED;
            PG8_LDB(B0, 1, 0); PG8_LDB(B1, 1, 1); PG8_SCHED; PG8_LDA(At, 1, 0); PG8_STAGE(PG8_SA(0, 1), a2 + hstep, voffA);
            PG8_WAIT_V(8); PG8_WAIT_L(0); PG8_BAR; PG8_MMA(0, 0, At, B0); PG8_MMA(0, 1, At, B1); PG8_BAR; PG8_SCHED;
            PG8_LDA(At, 1, 1); PG8_STAGE(PG8_SB(1, 0), b3, voffB); PG8_STAGE(PG8_SB(1, 1), b3 + hstep, voffB); PG8_STAGE(PG8_SA(1, 0), a3, voffA);
            PG8_WAIT_V(8); PG8_WAIT_L(0); PG8_BAR; PG8_MMA(1, 0, At, B0); PG8_MMA(1, 1, At, B1); PG8_BAR; PG8_SCHED;
            } else {
            PG8_LDB(B0, 0, 0); PG8_SCHED; PG8_LDA(At, 0, 0); PG8_STAGE(PG8_SA(1, 1), a1 + hstep, voffA);
            PG8_WAIT_L(8); PG8_BAR; PG8_WAIT_L(0); PG8_MMA(0, 0, At, B0); PG8_BAR; PG8_SCHED;
            PG8_LDB(B1, 0, 1); PG8_STAGE(PG8_SB(0, 0), b2, voffB);
            PG8_BAR; PG8_WAIT_L(0); PG8_MMA(0, 1, At, B1); PG8_BAR;
            PG8_LDA(At, 0, 1); PG8_STAGE(PG8_SA(0, 0), a2, voffA);
            PG8_BAR; PG8_WAIT_L(0); PG8_MMA(1, 0, At, B0); PG8_BAR; PG8_SCHED;
            PG8_STAGE(PG8_SB(0, 1), b2 + hstep, voffB);
            PG8_WAIT_V(6); PG8_BAR; PG8_MMA(1, 1, At, B1); PG8_BAR;
            PG8_LDB(B0, 1, 0); PG8_SCHED; PG8_LDA(At, 1, 0); PG8_STAGE(PG8_SA(0, 1), a2 + hstep, voffA);
            PG8_WAIT_L(8); PG8_BAR; PG8_WAIT_L(0); PG8_MMA(0, 0, At, B0); PG8_BAR; PG8_SCHED;
            PG8_LDB(B1, 1, 1); PG8_STAGE(PG8_SB(1, 0), b3, voffB);
            PG8_BAR; PG8_WAIT_L(0); PG8_MMA(0, 1, At, B1); PG8_BAR;
            PG8_LDA(At, 1, 1); PG8_STAGE(PG8_SA(1, 0), a3, voffA);
            PG8_BAR; PG8_WAIT_L(0); PG8_MMA(1, 0, At, B0); PG8_BAR; PG8_SCHED;
            PG8_STAGE(PG8_SB(1, 1), b3 + hstep, voffB);
            PG8_WAIT_V(6); PG8_BAR; PG8_MMA(1, 1, At, B1); PG8_BAR;
            }
        }
        if (ALIGN_EPI) { if (wr == 0) PG8_BAR; }
        if (!Epi::AFTER_DRAIN) E(acc, cur, wr, wc, fr, fq);
        if (!has_next) break;
#pragma unroll
        for (int a = 0; a < 2; ++a)
#pragma unroll
            for (int b = 0; b < 2; ++b)
#pragma unroll
                for (int m = 0; m < 4; ++m)
#pragma unroll
                    for (int n = 0; n < 2; ++n) acc[a][b][m][n] = (f32x4){0.f, 0.f, 0.f, 0.f};
        cur = nxt; cA = nA; cB = nB; ++ui;
        if (ALIGN_EPI) { if (wr == 1) PG8_BAR; }
    }
    PG8_WAIT_V(0);
    if (!ALIGN_EPI) { if (wr == 0) PG8_BAR; }
    PG8_BAR;
    if (Epi::AFTER_DRAIN) E.fused(acc, cur, wr, wc, fr, fq, lds, wid, lane);
#undef PG8_SA
#undef PG8_SB
#undef PG8_STAGE
#undef PG8_LDA
#undef PG8_LDB
#undef PG8_MMA
#undef PG8_WAIT_V
#undef PG8_WAIT_L
#undef PG8_BAR
#undef PG8_SCHED
}
}

typedef f32x4 AccT[2][2][4][2];

struct EpiSwiglu {
    static constexpr bool PERM = true, AFTER_DRAIN = false;
    __device__ __forceinline__ void fused(AccT&, const pg8::Unit&, int, int, int, int, LAS unsigned char*, int, int) const {}
    bf16_t* O;
    __device__ __forceinline__ void operator()(const AccT& acc, const pg8::Unit& u, int wr, int wc, int fr, int fq) const {
        const int row0 = u.pm * 256 + wr * 64 + fr, col0 = u.pn * 128 + wc * 32 + 8 * fq;
#pragma unroll
        for (int ai = 0; ai < 2; ++ai)
#pragma unroll
            for (int m = 0; m < 4; ++m) {
                bf16_t* rowp = O + (size_t)(row0 + ai * 128 + m * 16) * DFF + col0;
                const f32x4 g0 = acc[ai][0][m][0], g1 = acc[ai][0][m][1], u0 = acc[ai][1][m][0], u1 = acc[ai][1][m][1];
                const f32x4 v0 = swiglu4(g0, u0), v1 = swiglu4(g1, u1);
                u32x4 w; w.x = cvt_pk_bf16(v0[0], v0[1]); w.y = cvt_pk_bf16(v0[2], v0[3]); w.z = cvt_pk_bf16(v1[0], v1[1]); w.w = cvt_pk_bf16(v1[2], v1[3]);
                *(u32x4*)rowp = w;
            }
    }
};
struct EpiResid {
    static constexpr bool PERM = false, AFTER_DRAIN = false;
    __device__ __forceinline__ void fused(AccT&, const pg8::Unit&, int, int, int, int, LAS unsigned char*, int, int) const {}
    float* X; const float* gate; float coef;
    __device__ __forceinline__ void operator()(const AccT& acc, const pg8::Unit& u, int wr, int wc, int fr, int fq) const {
        const int row0 = u.pm * 256 + wr * 64 + fr, col0 = u.pn * 256 + wc * 32 + 4 * fq;
        const int b = u.pm >> 3;
        f32x4 gv[2][2];
#pragma unroll
        for (int bj = 0; bj < 2; ++bj)
#pragma unroll
            for (int n = 0; n < 2; ++n) gv[bj][n] = (*(const f32x4*)(gate + (size_t)b * (NMOD * D) + col0 + bj * 128 + n * 16) + 1.0f) * coef;
#pragma unroll
        for (int ai = 0; ai < 2; ++ai)
#pragma unroll
            for (int m = 0; m < 4; ++m) {
                float* rowp = X + (size_t)(row0 + ai * 128 + m * 16) * D + col0;
#pragma unroll
                for (int bj = 0; bj < 2; ++bj)
#pragma unroll
                    for (int n = 0; n < 2; ++n) { f32x4 x = *(const f32x4*)(rowp + bj * 128 + n * 16); x = x * ALPHA + gv[bj][n] * acc[ai][bj][m][n]; *(f32x4*)(rowp + bj * 128 + n * 16) = x; }
            }
    }
};

struct PanelStats {
    unsigned long long* xbuf; unsigned* cnt;
    __device__ __forceinline__ void run(const AccT& v, const pg8::Unit& u, int wr, int wc, int fr, int fq, LAS unsigned char* lds, int wid, int lane) const {
        LAS f32x2* P = (LAS f32x2*)lds;
        LAS f32x2* S = (LAS f32x2*)(lds + 8192);
#pragma unroll
        for (int ai = 0; ai < 2; ++ai)
#pragma unroll
            for (int m = 0; m < 4; ++m) {
                float s = 0.f;
#pragma unroll
                for (int bj = 0; bj < 2; ++bj)
#pragma unroll
                    for (int n = 0; n < 2; ++n) { const f32x4 x = v[ai][bj][m][n]; s += (x[0] + x[1]) + (x[2] + x[3]); }
                s = xsum32(xsum16(s));
                const float mw = s * (1.0f / 64.0f); float q = 0.f;
#pragma unroll
                for (int bj = 0; bj < 2; ++bj)
#pragma unroll
                    for (int n = 0; n < 2; ++n) { const f32x4 d = v[ai][bj][m][n] - mw; q += (d[0] * d[0] + d[1] * d[1]) + (d[2] * d[2] + d[3] * d[3]); }
                q = xsum32(xsum16(q));
                if (fq == 0) P[(ai * 128 + wr * 64 + m * 16 + fr) * 4 + wc] = (f32x2){mw, q};
            }
        asm volatile("s_waitcnt lgkmcnt(0)" ::: "memory"); __builtin_amdgcn_s_barrier(); asm volatile("" ::: "memory");
        const int row = wid * 32 + (lane & 31);
        if (lane < 32) {
            const f32x2 a = P[row * 4 + 0], b = P[row * 4 + 1], c = P[row * 4 + 2], d = P[row * 4 + 3];
            const float mt = (a.x + b.x + c.x + d.x) * 0.25f;
            const float da = a.x - mt, db = b.x - mt, dc = c.x - mt, dd = d.x - mt;
            const float m2 = (a.y + b.y) + (c.y + d.y) + 64.0f * ((da * da + db * db) + (dc * dc + dd * dd));
            unsigned long long* slot = xbuf + ((size_t)(u.pm * 256 + row) * 4 + u.pn);
            __hip_atomic_store(slot, ((unsigned long long)__float_as_uint(m2) << 32) | __float_as_uint(mt), __ATOMIC_RELAXED, __HIP_MEMORY_SCOPE_AGENT);
        }
        asm volatile("s_waitcnt vmcnt(0)" ::: "memory");
        if (lane == 0) __hip_atomic_fetch_add(cnt + 64 * u.pm, 1u, __ATOMIC_RELAXED, __HIP_MEMORY_SCOPE_AGENT);
        if (wid == 0) {
            while ((unsigned)__builtin_amdgcn_readfirstlane(__hip_atomic_load(cnt + 64 * u.pm, __ATOMIC_RELAXED, __HIP_MEMORY_SCOPE_AGENT)) < 32u) __builtin_amdgcn_s_sleep(2);
            __builtin_amdgcn_fence(__ATOMIC_ACQUIRE, "agent");
        }
        asm volatile("s_waitcnt vmcnt(0) lgkmcnt(0)" ::: "memory"); __builtin_amdgcn_s_barrier(); asm volatile("" ::: "memory");
        if (lane < 32) {
            const unsigned long long* slot = xbuf + (size_t)(u.pm * 256 + row) * 4; float mt[4], m2[4]; float ms = 0.f;
#pragma unroll
            for (int t = 0; t < 4; ++t) { const unsigned long long w = __hip_atomic_load(slot + t, __ATOMIC_RELAXED, __HIP_MEMORY_SCOPE_AGENT); mt[t] = __uint_as_float((unsigned)w); m2[t] = __uint_as_float((unsigned)(w >> 32)); ms += mt[t]; }
            const float mean = ms * 0.25f; float q = 0.f;
#pragma unroll
            for (int t = 0; t < 4; ++t) { const float dm = mt[t] - mean; q += m2[t] + 256.0f * dm * dm; }
            S[row] = (f32x2){mean, 1.0f / sqrtf(q * (1.0f / 1024.0f) + LN_EPS)};
        }
        asm volatile("s_waitcnt lgkmcnt(0)" ::: "memory"); __builtin_amdgcn_s_barrier(); asm volatile("" ::: "memory");
    }
};
template <bool F32> __device__ __forceinline__ f32x4 ldx4(const void* base, size_t off) {
    if (F32) return *(const f32x4*)((const float*)base + off);
    else return __builtin_convertvector(*(const h16x4*)((const _Float16*)base + off), f32x4);
}
template <bool F32> __device__ __forceinline__ void stx4(void* base, size_t off, f32x4 v) {
    if (F32) *(f32x4*)((float*)base + off) = v;
    else *(h16x4*)((_Float16*)base + off) = __builtin_convertvector(v, h16x4);
}
struct EpiResidLn {
    static constexpr bool PERM = true, AFTER_DRAIN = true;
    const void* Xin; void* Xout; const float* gate; const float* gam; const float* bet;
    const float* modn; bf16_t* H; const float* mkv; bf16_t* HKV; PanelStats st; float coef; int xout32;
    __device__ __forceinline__ void operator()(const AccT&, const pg8::Unit&, int, int, int, int) const {}
    __device__ __forceinline__ void load_resid(AccT& acc, const f32x4 (&gv)[2][2], size_t row0, int col0) const {
        const _Float16* X16 = (const _Float16*)Xin;
#pragma unroll
        for (int ai = 0; ai < 2; ++ai)
#pragma unroll
            for (int m = 0; m < 4; ++m) {
                const size_t roff = (row0 + ai * 128 + m * 16) * D + col0;
#pragma unroll
                for (int bj = 0; bj < 2; ++bj) {
                    const h16x8 hv = *(const h16x8*)(X16 + roff + bj * 128);
                    const f32x4 x0 = __builtin_convertvector(__builtin_shufflevector(hv, hv, 0, 1, 2, 3), f32x4), x1 = __builtin_convertvector(__builtin_shufflevector(hv, hv, 4, 5, 6, 7), f32x4);
                    acc[ai][bj][m][0] = x0 * ALPHA + gv[bj][0] * acc[ai][bj][m][0];
                    acc[ai][bj][m][1] = x1 * ALPHA + gv[bj][1] * acc[ai][bj][m][1];
                }
                asm volatile("" : "+v"(acc[ai][0][m][0]), "+v"(acc[ai][0][m][1]), "+v"(acc[ai][1][m][0]), "+v"(acc[ai][1][m][1]));
            }
    }
    template <bool F32> __device__ __forceinline__ void store_out(const AccT& acc, const LAS f32x2* S, const LAS float* PAR, size_t prow0, int rl0, int cl0, int col0) const {
#pragma unroll
        for (int ai = 0; ai < 2; ++ai)
#pragma unroll
            for (int m = 0; m < 4; ++m) {
                const int rl = rl0 + ai * 128 + m * 16;
                const f32x2 sr = S[rl];
                const size_t off = (prow0 + rl) * D + col0;
#pragma unroll
                for (int bj = 0; bj < 2; ++bj) {
                    f32x4 v[2];
#pragma unroll
                    for (int n = 0; n < 2; ++n) {
                        const int cl = cl0 + bj * 128 + n * 4;
                        const f32x4 g4 = *(const LAS f32x4*)(PAR + cl), b4 = *(const LAS f32x4*)(PAR + 256 + cl);
                        v[n] = (acc[ai][bj][m][n] - sr.x) * sr.y * g4 + b4;
                    }
                    if (F32) { *(f32x4*)((float*)Xout + off + bj * 128) = v[0]; *(f32x4*)((float*)Xout + off + bj * 128 + 4) = v[1]; }
                    else { const h16x4 a = __builtin_convertvector(v[0], h16x4), b = __builtin_convertvector(v[1], h16x4); *(h16x8*)((_Float16*)Xout + off + bj * 128) = __builtin_shufflevector(a, b, 0, 1, 2, 3, 4, 5, 6, 7); }
                    if (modn) {
                        u32x4 w;
#pragma unroll
                        for (int n = 0; n < 2; ++n) { const int cl = cl0 + bj * 128 + n * 4; const f32x4 hh = v[n] * *(const LAS f32x4*)(PAR + 768 + cl) + *(const LAS f32x4*)(PAR + 512 + cl);
                            w[2 * n] = cvt_pk_bf16(hh[0], hh[1]); w[2 * n + 1] = cvt_pk_bf16(hh[2], hh[3]); }
                        *(u32x4*)(H + off + bj * 128) = w;
                    }
                    if (mkv) {
                        u32x4 w;
#pragma unroll
                        for (int n = 0; n < 2; ++n) { const int cl = cl0 + bj * 128 + n * 4; const f32x4 hh = v[n] * *(const LAS f32x4*)(PAR + 1280 + cl) + *(const LAS f32x4*)(PAR + 1024 + cl);
                            w[2 * n] = cvt_pk_bf16(hh[0], hh[1]); w[2 * n + 1] = cvt_pk_bf16(hh[2], hh[3]); }
                        *(u32x4*)(HKV + off + bj * 128) = w;
                    }
                }
            }
    }
    __device__ __forceinline__ void fused(AccT& acc, const pg8::Unit& u, int wr, int wc, int fr, int fq, LAS unsigned char* lds, int wid, int lane) const {
        const LAS f32x2* S = (const LAS f32x2*)(lds + 8192);
        LAS float* PAR = (LAS float*)(lds + 16384);
        const int rl0 = wr * 64 + fr, cl0 = wc * 32 + 8 * fq, col0 = u.pn * 256 + cl0;
        const int b = u.pm >> 3;
        f32x4 pv = (f32x4){0.f, 0.f, 0.f, 0.f};
        {
            const int c = u.pn * 256 + lane * 4;
            if (wid == 0) pv = *(const f32x4*)(gam + c);
            else if (wid == 1) pv = *(const f32x4*)(bet + c);
            else if (wid == 2) { if (modn) pv = *(const f32x4*)(modn + (size_t)b * 9216 + c); }
            else if (wid == 3) { if (modn) pv = *(const f32x4*)(modn + (size_t)b * 9216 + 1024 + c) + 1.0f; }
            else if (wid == 4) { if (mkv) pv = *(const f32x4*)(mkv + (size_t)b * 2048 + c); }
            else if (wid == 5) { if (mkv) pv = *(const f32x4*)(mkv + (size_t)b * 2048 + 1024 + c) + 1.0f; }
        }
        {
            f32x4 gv[2][2];
#pragma unroll
            for (int bj = 0; bj < 2; ++bj)
#pragma unroll
                for (int n = 0; n < 2; ++n) gv[bj][n] = (*(const f32x4*)(gate + (size_t)b * (NMOD * D) + col0 + bj * 128 + n * 4) + 1.0f) * coef;
            load_resid(acc, gv, (size_t)(u.pm * 256 + rl0), col0);
        }
        if (wid < 6) *(LAS f32x4*)(PAR + wid * 256 + lane * 4) = pv;
        st.run(acc, u, wr, wc, fr, fq, lds, wid, lane);
        if (xout32) store_out<true>(acc, S, PAR, (size_t)u.pm * 256, rl0, cl0, col0); else store_out<false>(acc, S, PAR, (size_t)u.pm * 256, rl0, cl0, col0);
    }
};
template <int BIAS, bool GELU, bool STATS>
struct EpiBf16 {
    static constexpr bool PERM = true, AFTER_DRAIN = false;
    __device__ __forceinline__ void fused(AccT&, const pg8::Unit&, int, int, int, int, LAS unsigned char*, int, int) const {}
    bf16_t* O; int ldc; const float* bias; float scale; float* stats;
    __device__ __forceinline__ void operator()(const AccT& acc, const pg8::Unit& u, int wr, int wc, int fr, int fq) const {
        const int row0 = u.pm * 256 + wr * 64 + fr, col0 = u.pn * 256 + wc * 32 + 8 * fq;
        f32x4 bv[2][2];
#pragma unroll
        for (int bj = 0; bj < 2; ++bj)
#pragma unroll
            for (int n = 0; n < 2; ++n) bv[bj][n] = (BIAS == 1) ? *(const f32x4*)(bias + col0 + bj * 128 + 4 * n) : (f32x4){0.f, 0.f, 0.f, 0.f};
        f32x4 cs[2][2], cq[2][2];
#pragma unroll
        for (int bj = 0; bj < 2; ++bj)
#pragma unroll
            for (int n = 0; n < 2; ++n) { cs[bj][n] = (f32x4){0.f, 0.f, 0.f, 0.f}; cq[bj][n] = (f32x4){0.f, 0.f, 0.f, 0.f}; }
#pragma unroll
        for (int ai = 0; ai < 2; ++ai)
#pragma unroll
            for (int m = 0; m < 4; ++m) {
                const int r = row0 + ai * 128 + m * 16;
                bf16_t* rowp = O + (size_t)r * ldc + col0;
                float rb = 0.f; if (BIAS == 2) rb = bias[r];
#pragma unroll
                for (int bj = 0; bj < 2; ++bj) {
                    f32x4 v0 = acc[ai][bj][m][0] + bv[bj][0], v1 = acc[ai][bj][m][1] + bv[bj][1];
                    if (BIAS == 2) { v0 = v0 + rb; v1 = v1 + rb; }
                    if (GELU) { v0 = gelu4(v0); v1 = gelu4(v1); } else { v0 = v0 * scale; v1 = v1 * scale; }
                    if (STATS) { cs[bj][0] += v0; cs[bj][1] += v1; cq[bj][0] += v0 * v0; cq[bj][1] += v1 * v1; }
                    u32x4 w; w.x = cvt_pk_bf16(v0[0], v0[1]); w.y = cvt_pk_bf16(v0[2], v0[3]); w.z = cvt_pk_bf16(v1[0], v1[1]); w.w = cvt_pk_bf16(v1[2], v1[3]);
                    *(u32x4*)(rowp + bj * 128) = w;
                }
            }
        if (STATS) {
            float sel_s = 0.f, sel_q = 0.f;
#pragma unroll
            for (int bj = 0; bj < 2; ++bj)
#pragma unroll
                for (int n = 0; n < 2; ++n)
#pragma unroll
                    for (int j = 0; j < 4; ++j) {
                        const float s = dpp_sum16(cs[bj][n][j]), q = dpp_sum16(cq[bj][n][j]);
                        const int i = bj * 8 + n * 4 + j;
                        if (fr == i) { sel_s = s; sel_q = q; }
                    }
            const int ccol = col0 + (fr >> 3) * 128 + ((fr >> 2) & 1) * 4 + (fr & 3);
            *(f32x2*)(stats + ((size_t)(u.pm * 2 + wr) * ldc + ccol) * 2) = (f32x2){sel_s, sel_q};
        }
    }
};

__device__ __forceinline__ void conv_ld(f32x4 (&v)[4], const float* src, int N, int kt, int ntile, int gu) {
    const int tid = threadIdx.x;
    const int k0 = kt * 64, n0 = ntile * 128;
    int srccol0 = n0;
    if (gu) { const int pn = n0 >> 8, bj = (n0 >> 7) & 1; srccol0 = bj * DFF + pn * 128; }
    const int n4 = (tid & 31) * 4, kk = tid >> 5;
#pragma unroll
    for (int i = 0; i < 4; ++i) v[i] = __builtin_nontemporal_load((const f32x4*)(src + (size_t)(k0 + kk + 16 * i) * N + srccol0 + n4));
}
__device__ __forceinline__ void conv_scatter(LAS unsigned char* lds, const f32x4 (&v)[4]) {
    LAS float* T = (LAS float*)lds;
    const int tid = threadIdx.x;
    const int n4 = (tid & 31) * 4, kk = tid >> 5;
#pragma unroll
    for (int i = 0; i < 4; ++i) { const int k = kk + 16 * i; T[(n4 + 0) * 65 + k] = v[i][0]; T[(n4 + 1) * 65 + k] = v[i][1]; T[(n4 + 2) * 65 + k] = v[i][2]; T[(n4 + 3) * 65 + k] = v[i][3]; }
}
__device__ __forceinline__ void conv_st(LAS unsigned char* lds, int K, bf16_t* dst, int kt, int ntile) {
    LAS float* T = (LAS float*)lds;
    const int tid = threadIdx.x;
    const int k0 = kt * 64, n0 = ntile * 128;
#pragma unroll
    for (int i = 0; i < 2; ++i) {
        const int n = (tid >> 3) + 64 * i, k8 = (tid & 7) * 8;
        float f[8];
#pragma unroll
        for (int j = 0; j < 8; ++j) f[j] = T[n * 65 + k8 + j];
        u32x4 w; w.x = cvt_pk_bf16(f[0], f[1]); w.y = cvt_pk_bf16(f[2], f[3]); w.z = cvt_pk_bf16(f[4], f[5]); w.w = cvt_pk_bf16(f[6], f[7]);
        *(u32x4*)(dst + (size_t)(n0 + n) * K + k0 + k8) = w;
    }
}
struct CJob { const float* src; bf16_t* dst; int K, N, gu, ntiles; };
__device__ __forceinline__ CJob cjob(const float* src, bf16_t* dst, int K, int N, int gu) { CJob j; j.src = src; j.dst = dst; j.K = K; j.N = N; j.gu = gu; j.ntiles = (K >> 6) * (N >> 7); return j; }
__device__ __forceinline__ CJob cjob_none() { CJob j; j.src = nullptr; j.dst = nullptr; j.K = 64; j.N = 128; j.gu = 0; j.ntiles = 0; return j; }
__device__ __forceinline__ CJob cjob_id(int id) {
    unsigned char* ws = WSP();
    if (id < 0) return cjob_none();
    if (id < 8) return cjob(IN(6) + (size_t)id * 1024 * 5632, (bf16_t*)(ws + WS_WGU) + (size_t)id * 1024 * 5632, 1024, 5632, 1);
    if (id < 16) { const int m = id - 8; return cjob(IN(7) + (size_t)m * 2816 * 1024, (bf16_t*)(ws + WS_WDOWN) + (size_t)m * 2816 * 1024, 2816, 1024, 0); }
    if (id < 18) { const int m = id - 16; return cjob(IN(8) + (size_t)m * 1024 * 4096, (bf16_t*)(ws + WS_WIN) + (size_t)m * 1024 * 4096, 1024, 4096, 0); }
    if (id < 20) { const int m = id - 18; return cjob(IN(14) + (size_t)m * 2048 * 1024, (bf16_t*)(ws + WS_WOUT) + (size_t)m * 2048 * 1024, 2048, 1024, 0); }
    if (id == 20) return cjob(IN(17), (bf16_t*)(ws + WS_WKV), 1024, 2048, 0);
    if (id < 23) { const int m = id - 21; return cjob(IN(18) + (size_t)m * 1024 * 1024, (bf16_t*)(ws + WS_WQ) + (size_t)m * 1024 * 1024, 1024, 1024, 0); }
    { const int m = id - 23; return cjob(IN(20) + (size_t)m * 1024 * 1024, (bf16_t*)(ws + WS_WO) + (size_t)m * 1024 * 1024, 1024, 1024, 0); }
}
__device__ __forceinline__ void conv_multi(LAS unsigned char* lds, int ia, int ib, int ic, int id, int j, int nj) {
    const CJob a = cjob_id(ia), b = cjob_id(ib), c = cjob_id(ic), d = cjob_id(id);
    const int T = a.ntiles + b.ntiles + c.ntiles + d.ntiles;
#define CONV_SEL(t, x, tt) do { tt = (t); x = a; if (tt >= a.ntiles) { tt -= a.ntiles; x = b; if (tt >= b.ntiles) { tt -= b.ntiles; x = c; if (tt >= c.ntiles) { tt -= c.ntiles; x = d; } } } } while (0)
    if (j >= T) return;
    f32x4 v[4];
    CJob x; int tt;
    CONV_SEL(j, x, tt);
    conv_ld(v, x.src, x.N, tt / (x.N >> 7), tt % (x.N >> 7), x.gu);
#define CONV_BAR() do { asm volatile("s_waitcnt lgkmcnt(0)" ::: "memory"); __builtin_amdgcn_s_barrier(); asm volatile("" ::: "memory"); } while (0)
    for (int t = j; t < T; t += nj) {
        conv_scatter(lds, v);
        CONV_BAR();
        const CJob cur = x; const int ct = tt;
        if (t + nj < T) { CONV_SEL(t + nj, x, tt); conv_ld(v, x.src, x.N, tt / (x.N >> 7), tt % (x.N >> 7), x.gu); }
        conv_st(lds, cur.K, cur.dst, ct / (cur.N >> 7), ct % (cur.N >> 7));
        CONV_BAR();
    }
#undef CONV_BAR
#undef CONV_SEL
}

__device__ void p0_phase(LAS unsigned char* lds) {
    const int tid = threadIdx.x, G = gridDim.x, bx = blockIdx.x;
    unsigned char* ws = WSP();
    {
        const float* wsrc = IN(12); bf16_t* wd = (bf16_t*)(ws + WS_WSB);
        for (int i = bx * NTHREADS + tid; i < 2 * 8 * 128 * 128; i += G * NTHREADS) {
            const int t = (i >> 7) & 127, s = i & 127;
            const float v = ((s >> 6) <= (t >> 6)) ? wsrc[i] : 0.f;
            wd[i] = (bf16_t)(cvt_pk_bf16(v, 0.f) & 0xffffu);
        }
    }
    {
        LAS float* SC = (LAS float*)lds;
        LAS float* PART = (LAS float*)(lds + 32768);
        const float* c = IN(1);
        for (int i = tid; i < NB * D; i += NTHREADS) SC[i] = silu_f(c[i]);
        __syncthreads();
        const int wave = tid >> 6, lane = tid & 63;
        {
            const int J = bx * 152 + 4 * (lane < 38 ? lane : 0);
            const float* wp; int ld;
            if (J < 36864) { const int l = J / 9216, jj = J - l * 9216; wp = IN(2) + (size_t)l * D * 9216 + jj; ld = 9216; }
            else { wp = IN(15) + (J - 36864); ld = 2048; }
            wp += (size_t)(wave * 128) * ld;
            f32x4 a[8];
#pragma unroll
            for (int b = 0; b < 8; ++b) a[b] = (f32x4){0.f, 0.f, 0.f, 0.f};
            if (lane < 38) {
                for (int k = 0; k < 128; k += 8) {
                    f32x4 wv[8];
#pragma unroll
                    for (int kk = 0; kk < 8; ++kk) wv[kk] = __builtin_nontemporal_load((const f32x4*)(wp + (size_t)(k + kk) * ld));
#pragma unroll
                    for (int b = 0; b < 8; ++b) {
                        const f32x4 s0 = *(const LAS f32x4*)(SC + b * 1024 + wave * 128 + k), s1 = *(const LAS f32x4*)(SC + b * 1024 + wave * 128 + k + 4);
                        a[b] += wv[0] * s0[0] + wv[1] * s0[1] + wv[2] * s0[2] + wv[3] * s0[3] + wv[4] * s1[0] + wv[5] * s1[1] + wv[6] * s1[2] + wv[7] * s1[3];
                    }
                }
            }
#pragma unroll
            for (int b = 0; b < 8; ++b) *(LAS f32x4*)(PART + (wave * 64 + lane) * 32 + b * 4) = a[b];
        }
        __syncthreads();
        if (tid < 304) {
            const int b = tid / 38, L = tid - b * 38;
            f32x4 s = (f32x4){0.f, 0.f, 0.f, 0.f};
#pragma unroll
            for (int w = 0; w < 8; ++w) s += *(const LAS f32x4*)(PART + (w * 64 + L) * 32 + b * 4);
            const int J = bx * 152 + 4 * L;
            if (J < 36864) { const int l = J / 9216, jj = J - l * 9216; *(f32x4*)((float*)(ws + WS_MOD) + (size_t)(l * 8 + b) * 9216 + jj) = s + *(const f32x4*)(IN(3) + l * 9216 + jj); }
            else { const int jj = J - 36864; *(f32x4*)((float*)(ws + WS_MKV) + b * 2048 + jj) = s + *(const f32x4*)(IN(16) + jj); }
        }
        __syncthreads();
    }
    conv_multi(lds, 0, 8, 16, 18, bx, G);
}

__device__ void p0b_phase() {
    unsigned char* ws = WSP();
    const float* x = IN(0); bf16_t* H = (bf16_t*)(ws + WS_H);
    const float* mod = (const float*)(ws + WS_MOD);
    for (int i = blockIdx.x * NTHREADS + threadIdx.x; i < MTOK * D / 8; i += gridDim.x * NTHREADS) {
        const int row = i >> 7, c = (i & 127) * 8, b = row >> 11;
        const f32x4 v0 = __builtin_nontemporal_load((const f32x4*)(x + (size_t)i * 8)), v1 = __builtin_nontemporal_load((const f32x4*)(x + (size_t)i * 8 + 4));
        const float* mb = mod + (size_t)b * 9216 + c;
        const f32x4 h0 = v0 * (*(const f32x4*)(mb + 1024) + 1.0f) + *(const f32x4*)mb, h1 = v1 * (*(const f32x4*)(mb + 1028) + 1.0f) + *(const f32x4*)(mb + 4);
        u32x4 w; w.x = cvt_pk_bf16(h0[0], h0[1]); w.y = cvt_pk_bf16(h0[2], h0[3]); w.z = cvt_pk_bf16(h1[0], h1[1]); w.w = cvt_pk_bf16(h1[2], h1[3]);
        *(u32x4*)(H + (size_t)i * 8) = w;
        const h16x4 a = __builtin_convertvector(v0, h16x4), bb = __builtin_convertvector(v1, h16x4);
        *(h16x8*)((_Float16*)(ws + WS_X) + (size_t)i * 8) = __builtin_shufflevector(a, bb, 0, 1, 2, 3, 4, 5, 6, 7);
    }
}

__device__ void ln_phase(const float* X, float* XO, const float* gam, const float* bet, const float* modn  ,
                         bf16_t* H, const float* mkv  , bf16_t* HKV) {
    const int tid = opaque_tid(), lane = tid & 63, wave = tid >> 6;
    const int nwaves = gridDim.x * 8;
    for (int gw = blockIdx.x * 8 + wave; gw < MTOK / 8; gw += nwaves) {
        const int b = gw >> 8;
        f32x4 g4[4], b4[4];
#pragma unroll
        for (int i = 0; i < 4; ++i) { g4[i] = *(const f32x4*)(gam + 4 * lane + 256 * i); b4[i] = *(const f32x4*)(bet + 4 * lane + 256 * i); }
        for (int rr = 0; rr < 8; ++rr) {
            const size_t row = (size_t)gw * 8 + rr;
            const float* xp = X + row * D + 4 * lane;
            f32x4 v[4];
#pragma unroll
            for (int i = 0; i < 4; ++i) v[i] = *(const f32x4*)(xp + 256 * i);
            float s = 0.f;
#pragma unroll
            for (int i = 0; i < 4; ++i) s += (v[i][0] + v[i][1]) + (v[i][2] + v[i][3]);
            s = wave_sum(s);
            const float mean = s * (1.0f / 1024.0f);
            float q = 0.f;
#pragma unroll
            for (int i = 0; i < 4; ++i) { v[i] = v[i] - mean; q += (v[i][0] * v[i][0] + v[i][1] * v[i][1]) + (v[i][2] * v[i][2] + v[i][3] * v[i][3]); }
            q = wave_sum(q);
            const float rstd = 1.0f / sqrtf(q * (1.0f / 1024.0f) + LN_EPS);
#pragma unroll
            for (int i = 0; i < 4; ++i) { v[i] = v[i] * rstd * g4[i] + b4[i]; *(f32x4*)(XO + row * D + 4 * lane + 256 * i) = v[i]; }
            if (modn) {
#pragma unroll
                for (int i = 0; i < 4; ++i) {
                    const f32x4 sh = *(const f32x4*)(modn + (size_t)b * 9216 + 4 * lane + 256 * i), sc = *(const f32x4*)(modn + (size_t)b * 9216 + 1024 + 4 * lane + 256 * i);
                    const f32x4 h = v[i] * (sc + 1.0f) + sh;
                    u32x2 w; w.x = cvt_pk_bf16(h[0], h[1]); w.y = cvt_pk_bf16(h[2], h[3]);
                    *(u32x2*)(H + row * D + 4 * lane + 256 * i) = w;
                }
            }
            if (mkv) {
#pragma unroll
                for (int i = 0; i < 4; ++i) {
                    const f32x4 sh = *(const f32x4*)(mkv + (size_t)b * 2048 + 4 * lane + 256 * i), sc = *(const f32x4*)(mkv + (size_t)b * 2048 + 1024 + 4 * lane + 256 * i);
                    const f32x4 h = v[i] * (sc + 1.0f) + sh;
                    u32x2 w; w.x = cvt_pk_bf16(h[0], h[1]); w.y = cvt_pk_bf16(h[2], h[3]);
                    *(u32x2*)(HKV + row * D + 4 * lane + 256 * i) = w;
                }
            }
        }
    }
}

constexpr int SP_PITCH = 272;
__device__ void spatial_phase(LAS unsigned char* lds, const bf16_t* wsb  , const bf16_t* VT  , const float* vstat  ,
                              const float* lng, const float* lnb  , const float* bs  , const bf16_t* U  , bf16_t* UO) {
    const int tid = opaque_tid(), lane = tid & 63, wave = __builtin_amdgcn_readfirstlane(tid >> 6), r = lane & 15, q = lane >> 4;
    LAS unsigned char* WSL = lds;
    LAS unsigned char* VTL = lds + 128 * SP_PITCH;
    const int g = blockIdx.x & 7;
    const int s8 = tid & 15, clb = tid >> 4;
    if ((int)blockIdx.x >= 1024) return;
#pragma unroll
    for (int i = 0; i < 4; ++i) {
        const int pidx = tid + 512 * i, row = pidx >> 4, c16 = pidx & 15;
        const u32x4 w = *(const u32x4*)(wsb + (size_t)g * 16384 + row * 128 + c16 * 8);
        *(LAS u32x4*)(WSL + row * SP_PITCH + c16 * 16) = w;
    }
    LAS f32x2* GB = (LAS f32x2*)(lds + 384 * SP_PITCH);
    if (tid < 256) GB[tid] = (f32x2){lng[g * 256 + tid], lnb[g * 256 + tid]};
    LAS f32x2* MUS = (LAS f32x2*)(lds + 384 * SP_PITCH + 2048);
    for (int e = tid; e < 8 * 128; e += NTHREADS) {
        const int ui = e >> 7, tk = e & 127, unit_e = (int)blockIdx.x + (int)gridDim.x * ui;
        if (unit_e < 1024) {
            const size_t tok = (size_t)(unit_e >> 3) * 128 + tk;
            float s = 0.f, qq = 0.f;
#pragma unroll
            for (int pz = 0; pz < 16; ++pz) { const f32x2 pr = *(const f32x2*)(vstat + ((size_t)pz * MTOK + tok) * 2); s += pr.x; qq += pr.y; }
            const float mu = s * (1.0f / 2048.0f);
            MUS[e] = (f32x2){mu, 1.0f / sqrtf(fmaxf(qq * (1.0f / 2048.0f) - mu * mu, 0.f) + LN_EPS)};
        }
    }
    __syncthreads();
    float bst[8];
#pragma unroll
    for (int tt = 0; tt < 8; ++tt) bst[tt] = bs[g * 128 + 16 * tt + r];
    u32x4 vreg[8];
#define SP_LOAD(unit) do { const size_t _tok0 = (size_t)((unit) >> 3) * 128; \
        _Pragma("unroll") for (int i = 0; i < 8; ++i) vreg[i] = *(const u32x4*)(VT + (size_t)(g * 256 + clb + 32 * i) * MTOK + _tok0 + s8 * 8); } while (0)
    SP_LOAD(blockIdx.x);
    for (int unit = blockIdx.x; unit < 1024; unit += gridDim.x) {
        const size_t tok0 = (size_t)(unit >> 3) * 128;
        {
            float mu8[8], rs8[8];
            const int uidx = (unit - (int)blockIdx.x) / (int)gridDim.x;
#pragma unroll
            for (int j = 0; j < 8; ++j) { const f32x2 mr = MUS[uidx * 128 + s8 * 8 + j]; mu8[j] = mr.x; rs8[j] = mr.y; }
#pragma unroll
            for (int i = 0; i < 8; ++i) {
                const u32x4 w = vreg[i];
                const f32x2 gb = GB[clb + 32 * i];
                float f[8];
                f[0] = bf16_lo(w.x); f[1] = bf16_hi(w.x); f[2] = bf16_lo(w.y); f[3] = bf16_hi(w.y); f[4] = bf16_lo(w.z); f[5] = bf16_hi(w.z); f[6] = bf16_lo(w.w); f[7] = bf16_hi(w.w);
#pragma unroll
                for (int j = 0; j < 8; ++j) f[j] = (f[j] - mu8[j]) * rs8[j] * gb.x + gb.y;
                u32x4 o; o.x = cvt_pk_bf16(f[0], f[1]); o.y = cvt_pk_bf16(f[2], f[3]); o.z = cvt_pk_bf16(f[4], f[5]); o.w = cvt_pk_bf16(f[6], f[7]);
                *(LAS u32x4*)(VTL + (clb + 32 * i) * SP_PITCH + s8 * 16) = o;
            }
        }
        __syncthreads();
        u32x4 uw[8];
#pragma unroll
        for (int tt = 0; tt < 8; ++tt) uw[tt] = *(const u32x4*)(U + (tok0 + 16 * tt + r) * GH + g * 256 + 32 * wave + 8 * q);
        if (unit + (int)gridDim.x < 1024) SP_LOAD(unit + (int)gridDim.x);
#pragma unroll
        for (int th = 0; th < 2; ++th) {
            f32x4 acc[4][2];
#pragma unroll
            for (int t4 = 0; t4 < 4; ++t4)
#pragma unroll
                for (int cf = 0; cf < 2; ++cf) acc[t4][cf] = (f32x4){0.f, 0.f, 0.f, 0.f};
#pragma unroll
            for (int kk = 0; kk < (th == 0 ? 2 : 4); ++kk) {
                bf16x8 xf[2], yf[4];
#pragma unroll
                for (int cf = 0; cf < 2; ++cf) xf[cf] = *(const LAS bf16x8*)(VTL + (32 * wave + 8 * (r >> 2) + 4 * cf + (r & 3)) * SP_PITCH + (32 * kk + 8 * q) * 2);
#pragma unroll
                for (int t4 = 0; t4 < 4; ++t4) yf[t4] = *(const LAS bf16x8*)(WSL + (16 * (4 * th + t4) + r) * SP_PITCH + (32 * kk + 8 * q) * 2);
#pragma unroll
                for (int t4 = 0; t4 < 4; ++t4)
#pragma unroll
                    for (int cf = 0; cf < 2; ++cf) acc[t4][cf] = __builtin_amdgcn_mfma_f32_16x16x32_bf16(xf[cf], yf[t4], acc[t4][cf], 0, 0, 0);
            }
#pragma unroll
            for (int t4 = 0; t4 < 4; ++t4) {
                const int tt = 4 * th + t4;
                const size_t uoff = (tok0 + 16 * tt + r) * GH + g * 256 + 32 * wave + 8 * q;
                const f32x4 s0 = acc[t4][0] + bst[tt], s1 = acc[t4][1] + bst[tt];
                u32x4 o;
                o.x = cvt_pk_bf16(bf16_lo(uw[tt].x) * s0[0], bf16_hi(uw[tt].x) * s0[1]); o.y = cvt_pk_bf16(bf16_lo(uw[tt].y) * s0[2], bf16_hi(uw[tt].y) * s0[3]);
                o.z = cvt_pk_bf16(bf16_lo(uw[tt].z) * s1[0], bf16_hi(uw[tt].z) * s1[1]); o.w = cvt_pk_bf16(bf16_lo(uw[tt].w) * s1[2], bf16_hi(uw[tt].w) * s1[3]);
                *(u32x4*)(UO + uoff) = o;
            }
        }
        __syncthreads();
    }
#undef SP_LOAD
}

struct AttnState { float m; f32x4 O[4]; f32x4 L; };
__device__ __forceinline__ void attn_step2(AttnState& st, const bf16x8 (&qf)[2], const bf16x8 ones, LAS unsigned char* BUF, LAS float* TBL, int n, int kcA, bool vA, bool vB, int t, int r, int q) {
    f32x4 S[8];
    bf16x8 kf[8][2];
#pragma unroll
    for (int hf = 0; hf < 2; ++hf) {
        if (hf == 0 ? vA : vB) {
            LAS unsigned char* KL = BUF + hf * 16384;
            const int kc = kcA + hf;
            const int far = (n - kc >= 5) ? 1 : 0;
            const int m0 = far ? 0 : 319 - ((n - kc) * 64 + t - 4 * q);
#pragma unroll
            for (int j = 0; j < 4; ++j) {
                const int key = 16 * j + r;
                kf[4 * hf + j][0] = *(const LAS bf16x8*)(KL + key * 128 + ((q ^ (key & 7)) << 4));
                kf[4 * hf + j][1] = *(const LAS bf16x8*)(KL + key * 128 + (((4 + q) ^ (key & 7)) << 4));
                const int mj = far ? 0 : m0 + 16 * j;
                S[4 * hf + j] = *(const LAS f32x4*)(TBL + ((mj & 3) * 100 + (mj >> 2)) * 4);
            }
        }
    }
    float mx = st.m;
#pragma unroll
    for (int hf = 0; hf < 2; ++hf) {
        if (hf == 0 ? vA : vB) {
            __builtin_amdgcn_s_setprio(1);
#pragma unroll
            for (int j = 0; j < 4; ++j) {
                f32x4 sv = S[4 * hf + j];
                sv = __builtin_amdgcn_mfma_f32_16x16x32_bf16(kf[4 * hf + j][0], qf[0], sv, 0, 0, 0);
                sv = __builtin_amdgcn_mfma_f32_16x16x32_bf16(kf[4 * hf + j][1], qf[1], sv, 0, 0, 0);
                S[4 * hf + j] = sv;
            }
            __builtin_amdgcn_s_setprio(0);
        }
    }
    bf16x8 vf[2][2][4];
#pragma unroll
    for (int hf = 0; hf < 2; ++hf) {
        if (hf == 0 ? vA : vB) {
            LAS unsigned char* VL = BUF + hf * 16384 + 8192;
#pragma unroll
            for (int kb = 0; kb < 2; ++kb)
#pragma unroll
                for (int df = 0; df < 4; ++df) { const int d = 16 * df + r; vf[hf][kb][df] = *(const LAS bf16x8*)(VL + d * 128 + (((4 * kb + q) ^ (d & 7)) << 4)); }
        }
    }
#pragma unroll
    for (int hf = 0; hf < 2; ++hf) {
        if (hf == 0 ? vA : vB) {
#pragma unroll
            for (int j = 0; j < 4; ++j) { mx = fmaxf(fmaxf(mx, S[4 * hf + j][0]), S[4 * hf + j][1]); mx = fmaxf(fmaxf(mx, S[4 * hf + j][2]), S[4 * hf + j][3]); }
        }
    }
    mx = xmax32(xmax16(mx));
    const float alpha = __builtin_amdgcn_exp2f(st.m - mx);
    st.m = mx; st.L = st.L * alpha;
#pragma unroll
    for (int df = 0; df < 4; ++df) st.O[df] = st.O[df] * alpha;
#pragma unroll
    for (int hf = 0; hf < 2; ++hf) {
        if (hf == 0 ? vA : vB) {
#pragma unroll
            for (int j = 0; j < 4; ++j)
#pragma unroll
                for (int jj = 0; jj < 4; ++jj) S[4 * hf + j][jj] = __builtin_amdgcn_exp2f(S[4 * hf + j][jj] - mx);
#pragma unroll
            for (int kb = 0; kb < 2; ++kb) {
                const f32x4 p0 = S[4 * hf + 2 * kb], p1 = S[4 * hf + 2 * kb + 1];
                u32x4 pw; pw.x = cvt_pk_bf16(p0[0], p0[1]); pw.y = cvt_pk_bf16(p0[2], p0[3]); pw.z = cvt_pk_bf16(p1[0], p1[1]); pw.w = cvt_pk_bf16(p1[2], p1[3]);
                const bf16x8 pf = __builtin_bit_cast(bf16x8, pw);
                __builtin_amdgcn_s_setprio(1);
#pragma unroll
                for (int df = 0; df < 4; ++df) st.O[df] = __builtin_amdgcn_mfma_f32_16x16x32_bf16(vf[hf][kb][df], pf, st.O[df], 0, 0, 0);
                st.L = __builtin_amdgcn_mfma_f32_16x16x32_bf16(ones, pf, st.L, 0, 0, 0);
                __builtin_amdgcn_s_setprio(0);
            }
        }
    }
}
__device__ void attn_phase(LAS unsigned char* lds, const bf16_t* Q, bf16_t* AO, const bf16_t* KB, const bf16_t* VTB, const float* relb) {
    const int tid = opaque_tid(), lane = tid & 63, wave = __builtin_amdgcn_readfirstlane(tid >> 6), r = lane & 15, q = lane >> 4;
    const int qc = wave >> 2, qg = wave & 3;
    const int bx = blockIdx.x, G = gridDim.x;
    LAS float* TBL = (LAS float*)(lds + 65536);
    const int srow = tid >> 3, sc16 = tid & 7;
    const int kwoff = srow * 128 + ((sc16 ^ (srow & 7)) << 4);
    const int vg0 = 2 * sc16, vp0 = (vg0 & 8) + ((vg0 & 3) << 1) + ((vg0 >> 2) & 1), vp1 = (vg0 & 8) + (((vg0 + 1) & 3) << 1) + (((vg0 + 1) >> 2) & 1);
    const int vwoff0 = 8192 + srow * 128 + ((((vp0 >> 1) ^ (srow & 7)) << 4) | ((vp0 & 1) << 3));
    const int vwoff1 = 8192 + srow * 128 + ((((vp1 >> 1) ^ (srow & 7)) << 4) | ((vp1 & 1) << 3));
    bf16x8 ones;
#pragma unroll
    for (int x = 0; x < 8; ++x) ones[x] = (r == 0) ? (short)0x3F80 : (short)0;
    constexpr float LOG2E = 1.4426950408889634f;
    const int h = bx & 15, b = (bx >> 4) & 7;
    const int nun = (2048 - bx + G - 1) / G;
    if (nun <= 0) return;
    if (tid < 400) {
        const int s4 = tid / 100, k4 = tid - s4 * 100;
        f32x4 e;
#pragma unroll
        for (int x = 0; x < 4; ++x) { int dist = 319 - (4 * k4 + s4 + x); dist = dist < -63 ? -63 : (dist > 256 ? 256 : dist); e[x] = relb[h * 320 + dist + 63] * LOG2E; }
        *(LAS f32x4*)(TBL + tid * 4) = e;
    }
    const int t = 16 * qg + r;
    const bf16_t* kg = KB + ((size_t)b * SEQ + srow) * D + h * 64 + sc16 * 8;
    const bf16_t* vg = VTB + (size_t)(h * 64 + srow) * MTOK + (size_t)b * SEQ + sc16 * 8;
    const bf16_t* qg_p = Q + ((size_t)b * SEQ + (size_t)qc * 64 + t) * D + h * 64 + 8 * q;
#define U_NP(i) ((bx + G * (i)) >> 7)
#define U_P0(i) (U_NP(i) < 4 ? 4 - U_NP(i) : 0)
#define ATT_LOAD(R, i, p) do { const long _ko = (long)(2 * U_NP(i) - 8 + 2 * (p)) * 64; R##k0 = *(const u32x4*)(kg + _ko * D); R##v0 = *(const u32x4*)(vg + _ko); \
                               R##k1 = *(const u32x4*)(kg + (_ko + 64) * D); R##v1 = *(const u32x4*)(vg + _ko + 64); } while (0)
#define ATT_LOADQ(dst, i) do { const bf16_t* _qp = qg_p + (size_t)U_NP(i) * 128 * D; dst[0] = *(const bf16x8*)_qp; dst[1] = *(const bf16x8*)(_qp + 32); } while (0)
#define ATT_WRITE(R, bo) do { *(LAS u32x4*)(lds + (bo) + kwoff) = R##k0; *(LAS u32x2*)(lds + (bo) + vwoff0) = (u32x2){R##v0.x, R##v0.y}; *(LAS u32x2*)(lds + (bo) + vwoff1) = (u32x2){R##v0.z, R##v0.w}; \
                              *(LAS u32x4*)(lds + (bo) + 16384 + kwoff) = R##k1; *(LAS u32x2*)(lds + (bo) + 16384 + vwoff0) = (u32x2){R##v1.x, R##v1.y}; *(LAS u32x2*)(lds + (bo) + 16384 + vwoff1) = (u32x2){R##v1.z, R##v1.w}; } while (0)
#define ATT_ADV(i, p) do { if (++(p) > 4) { ++(i); (p) = ((i) < nun) ? U_P0(i) : 0; } } while (0)
#define ATT_ITER(X, Y, bc, bn) do { \
        if (ci > 0 && cp == U_P0(ci)) { qf[0] = qn[0]; qf[1] = qn[1]; st.m = -3.0e38f; st.L = (f32x4){0.f, 0.f, 0.f, 0.f}; _Pragma("unroll") for (int df = 0; df < 4; ++df) st.O[df] = (f32x4){0.f, 0.f, 0.f, 0.f}; } \
        if (li < nun) { ATT_LOAD(X, li, lp); if (lp == U_P0(li)) ATT_LOADQ(qn, li); ATT_ADV(li, lp); } \
        { const int _np = U_NP(ci), _n = 2 * _np + qc, _kc = 2 * _np - 8 + 2 * cp; const bool _va = (_kc >= _n - 8 && _kc <= _n), _vb = (_kc + 1 >= _n - 8 && _kc + 1 <= _n); \
          if (_va || _vb) attn_step2(st, qf, ones, lds + (bc), TBL, _n, _kc, _va, _vb, t, r, q); \
          if (cp == 4) { const float inv = 1.0f / __shfl(st.L[0], r); bf16_t* op = AO + ((size_t)b * SEQ + (size_t)_n * 64 + t) * D + h * 64 + 4 * q; \
            _Pragma("unroll") for (int df = 0; df < 4; ++df) { u32x2 o; o.x = cvt_pk_bf16(st.O[df][0] * inv, st.O[df][1] * inv); o.y = cvt_pk_bf16(st.O[df][2] * inv, st.O[df][3] * inv); *(u32x2*)(op + 16 * df) = o; } } } \
        ++g; \
        if (g < total) ATT_WRITE(Y, bn); \
        __syncthreads(); \
        ATT_ADV(ci, cp); \
    } while (0)
    int total = 0;
    for (int i = 0; i < nun; ++i) total += 5 - U_P0(i);
    int li = 0, lp = U_P0(0), ci = 0, cp = lp, g = 0;
    const u32x4 z4 = (u32x4){0u, 0u, 0u, 0u};
    u32x4 Ak0, Av0, Ak1, Av1, Bk0 = z4, Bv0 = z4, Bk1 = z4, Bv1 = z4;
    bf16x8 qf[2], qn[2];
    qn[0] = qn[1] = ones;
    AttnState st; st.m = -3.0e38f; st.L = (f32x4){0.f, 0.f, 0.f, 0.f};
#pragma unroll
    for (int df = 0; df < 4; ++df) st.O[df] = (f32x4){0.f, 0.f, 0.f, 0.f};
    ATT_LOAD(A, li, lp); ATT_LOADQ(qf, 0); ATT_ADV(li, lp);
    if (li < nun) { ATT_LOAD(B, li, lp); if (lp == U_P0(li)) ATT_LOADQ(qn, li); ATT_ADV(li, lp); }
    ATT_WRITE(A, 0);
    __syncthreads();
    for (;;) {
        ATT_ITER(A, B, 0, 32768);
        if (g >= total) break;
        ATT_ITER(B, A, 32768, 0);
        if (g >= total) break;
    }
#undef U_NP
#undef U_P0
#undef ATT_LOAD
#undef ATT_LOADQ
#undef ATT_WRITE
#undef ATT_ADV
#undef ATT_ITER
}

#define P_X ((float*)(WSP() + WS_X))
#define P_H ((bf16_t*)(WSP() + WS_H))
#define P_ACT ((bf16_t*)(WSP() + WS_ACT))
#define P_VT ((bf16_t*)(WSP() + WS_VT))
#define P_HKV ((bf16_t*)(WSP() + WS_VT))
#define P_KB ((bf16_t*)(WSP() + WS_KB))
#define P_VTB ((bf16_t*)(WSP() + WS_VTB))
#define P_MOD ((const float*)(WSP() + WS_MOD))
#define P_MKV ((const float*)(WSP() + WS_MKV))
#define P_W(off) ((const bf16_t*)(WSP() + (off)))
__global__ void __launch_bounds__(NTHREADS) fwd_megakernel(Params p) {
    extern __shared__ __attribute__((aligned(16))) unsigned char lds_raw[];
    LAS unsigned char* lds = (LAS unsigned char*)lds_raw;
    cg::grid_group grid = cg::this_grid();
    const int G = gridDim.x, bx = blockIdx.x;

    volatile LAS unsigned* bst = (volatile LAS unsigned*)(lds + LDS_STAGE);
    if (threadIdx.x < 4) bst[threadIdx.x] = 0u;
    __syncthreads();
#define GRID_BAR() do { XcdBarrier _b; _b.bar = (unsigned*)(WSP() + WS_BAR); _b.x = xb_xcc_id(); _b.st = bst; xcd_barrier(_b); } while (0)
    xcd_barrier_post((unsigned*)(WSP() + WS_BAR));
    if (gridDim.x == 0x7fffffffu) grid.sync();
    p0_phase(lds);
    GRID_BAR();
    p0b_phase();
    GRID_BAR();

#pragma unroll 1
    for (int sub = 0; sub < 12; ++sub) {
        const int l = sub / 3, i = sub - 3 * l;
        if (i != 1) {
            const int s = i >> 1;
            pg8::Gemm g{P_H, P_W(WS_WGU) + (size_t)(l * 2 + s) * 5632 * 1024, MTOK, 5632, D};
            pg8::StaticOrder S; S.init(MTOK, 5632, G, bx);
            EpiSwiglu E{P_ACT};
            pg8::gemm_phase<EpiSwiglu, true, true>(lds, g, S, E);
            if (bx >= 128 && sub < 10) {
                int ja, jb, jc = -1, jd = -1;
                if (sub == 0) { ja = 1; jb = 9; }
                else if (sub == 2) { ja = 2; jb = 10; jc = 17; }
                else if (sub == 3) { ja = 3; jb = 11; jc = 19; }
                else if (sub == 5) { ja = 4; jb = 12; jc = 20; }
                else if (sub == 6) { ja = 5; jb = 13; jc = 21; jd = 23; }
                else if (sub == 8) { ja = 6; jb = 14; jc = 22; jd = 24; }
                else { ja = 7; jb = 15; }
                conv_multi(lds, ja, jb, jc, jd, bx - 128, 128);
            }
        } else if (l < 2) {
            {
                pg8::Gemm g{P_H, P_W(WS_WIN) + (size_t)l * 4096 * 1024, MTOK, GH, D};
                pg8::StaticOrder S; S.init(MTOK, GH, G, bx);
                EpiBf16<1, true, false> E{P_ACT, GH, IN(9) + l * 4096, 1.0f, nullptr};
                pg8::gemm_phase<EpiBf16<1, true, false>, true, true>(lds, g, S, E);
            }
            {
                pg8::Gemm g{P_W(WS_WIN) + (size_t)l * 4096 * 1024 + (size_t)2048 * 1024, P_H, GH, MTOK, D};
                pg8::StaticOrder S; S.init(GH, MTOK, G, bx);
                EpiBf16<2, true, true> E{P_VT, MTOK, IN(9) + l * 4096 + 2048, 1.0f, (float*)(WSP() + WS_VPART) + (size_t)l * 16 * MTOK * 2};
                pg8::gemm_phase<EpiBf16<2, true, true>, true, true>(lds, g, S, E);
            }
            GRID_BAR();
            spatial_phase(lds, P_W(WS_WSB) + (size_t)l * 8 * 16384, P_VT, (const float*)(WSP() + WS_VPART) + (size_t)l * 16 * MTOK * 2,
                          IN(10) + l * GH, IN(11) + l * GH, IN(13) + l * 8 * 128, P_ACT, P_ACT);
        } else {
            const int j = l - 2;
            {
                pg8::Gemm g{P_H, P_W(WS_WQ) + (size_t)j * 1024 * 1024, MTOK, D, D};
                pg8::StaticOrder S; S.init(MTOK, D, G, bx);
                EpiBf16<0, false, false> E{P_ACT, D, nullptr, 0.125f * 1.4426950408889634f, nullptr};
                pg8::gemm_phase<EpiBf16<0, false, false>, true, true>(lds, g, S, E);
            }
            GRID_BAR();
            attn_phase(lds, P_ACT, P_ACT, P_KB, P_VTB, IN(19) + j * 16 * 320);
        }
        GRID_BAR();
        {
            const bf16_t* rB; int rK; float coef;
            if (i != 1) { rB = P_W(WS_WDOWN) + (size_t)(l * 2 + (i >> 1)) * 1024 * 2816; rK = DFF; coef = 0.5f; }
            else if (l < 2) { rB = P_W(WS_WOUT) + (size_t)l * 1024 * 2048; rK = GH; coef = 1.0f; }
            else { rB = P_W(WS_WO) + (size_t)(l - 2) * 1024 * 1024; rK = D; coef = 1.0f; }
            const bool last = (sub == 11);
            const int l2 = (i == 2) ? l + 1 : l, i2 = (i == 2) ? 0 : i + 1;
            const float* modn = last ? nullptr : P_MOD + (size_t)l2 * 8 * 9216 + (3 * i2) * 1024;
            pg8::Gemm g{P_ACT, rB, MTOK, D, rK};
            pg8::StaticOrder S; S.init(MTOK, D, G, bx);
            void* X = (void*)P_X;
            EpiResidLn E{(const void*)X, last ? (void*)OUTP() : X, P_MOD + (size_t)l * 8 * 9216 + (3 * i + 2) * 1024, IN(4) + (l * 3 + i) * D, IN(5) + (l * 3 + i) * D,
                         modn, P_H, (sub == 5) ? P_MKV : nullptr, P_HKV,
                         PanelStats{(unsigned long long*)(WSP() + WS_XBUF), (unsigned*)(WSP() + WS_CNT) + (size_t)sub * 64 * 64}, coef, last ? 1 : 0};
            pg8::gemm_phase<EpiResidLn, false, true>(lds, g, S, E);
        }
        if (sub == 11) break;
        GRID_BAR();
        if (sub == 5) {
            {
                pg8::Gemm g{P_HKV, P_W(WS_WKV), MTOK, D, D};
                pg8::StaticOrder S; S.init(MTOK, D, G, bx);
                EpiBf16<0, false, false> E{P_KB, D, nullptr, 1.0f, nullptr};
                pg8::gemm_phase<EpiBf16<0, false, false>, true, true>(lds, g, S, E);
            }
            {
                pg8::Gemm g{P_W(WS_WKV) + (size_t)1024 * 1024, P_HKV, D, MTOK, D};
                pg8::StaticOrder S; S.init(D, MTOK, G, bx);
                EpiBf16<0, false, false> E{P_VTB, MTOK, nullptr, 1.0f, nullptr};
                pg8::gemm_phase<EpiBf16<0, false, false>, true, true>(lds, g, S, E);
            }
        }
    }
}

extern "C" void kernel_launch(void* const* d_in, const int* in_sizes, int n_in, void* d_out, int out_size, void* d_ws, size_t ws_size, hipStream_t stream) {
    static int grid_blocks = 0;
    if (grid_blocks == 0) {
        if (n_in != 21 || ws_size < WS_END) { fprintf(stderr, "kernel_launch: expected 21 inputs and >= %zu bytes of workspace (got %d, %zu)\n", (size_t)WS_END, n_in, ws_size); grid_blocks = -1; return; }
        int dev = 0, cus = 0, per_cu = 0;
        hipGetDevice(&dev);
        hipDeviceGetAttribute(&cus, hipDeviceAttributeMultiprocessorCount, dev);
        if (hipFuncSetAttribute((const void*)fwd_megakernel, hipFuncAttributeMaxDynamicSharedMemorySize, LDS_BYTES) != hipSuccess) { fprintf(stderr, "kernel_launch: hipFuncSetAttribute failed\n"); grid_blocks = -1; return; }
        hipOccupancyMaxActiveBlocksPerMultiprocessor(&per_cu, (const void*)fwd_megakernel, NTHREADS, LDS_BYTES);
        if (per_cu < 1) { fprintf(stderr, "kernel_launch: occupancy query says %d blocks per CU\n", per_cu); per_cu = 1; }
        (void)hipGetLastError();
        grid_blocks = 256;
        if (cus < 256) { fprintf(stderr, "kernel_launch: this kernel needs 256 CUs (device has %d)\n", cus); grid_blocks = -1; return; }
    }
    if (grid_blocks < 0) return;
    Params p{};
    for (int i = 0; i < 21; ++i) p.in[i] = (const float*)d_in[i];
    p.out = (float*)d_out; p.ws = (unsigned char*)d_ws;
    if (hipMemsetAsync((unsigned char*)d_ws + WS_BAR, 0, WS_ZERO_END - WS_BAR, stream) != hipSuccess) { fprintf(stderr, "kernel_launch: hipMemsetAsync failed\n"); return; }
    void* args[] = {&p};
    hipError_t e = hipLaunchCooperativeKernel((const void*)fwd_megakernel, dim3(grid_blocks), dim3(NTHREADS), args, LDS_BYTES, stream);
    if (e != hipSuccess) fprintf(stderr, "cooperative launch failed: %s (grid %d)\n", hipGetErrorString(e), grid_blocks);
}
```
